# Optimizing an MI355X kernel written in HIP

```python
import math
import jax, jax.numpy as jnp
from jax import lax
import numpy as np

D_MODEL = 2048
BATCH = 4
SEQ = 4096
DEPTH = 2

MEM_LEN = 256
CHUNK = 128
GMLP_WIDTH = 1024
GMLP_GROUPS = 8
GMLP_GROUP_DIM = GMLP_WIDTH // GMLP_GROUPS
N_Q_HEADS = 16
N_KV_HEADS = 4
HEAD_DIM = 64
ATTN_WIDTH = N_Q_HEADS * HEAD_DIM
KV_WIDTH = N_KV_HEADS * HEAD_DIM
WINDOW = 128
ROPE_THETA = 10000.0
X_HEADS = 4
X_HEAD_DIM = 128
X_WIDTH = X_HEADS * X_HEAD_DIM
D_FF = 4 * D_MODEL
LN_EPS = 1e-5
ALPHA = (2 * DEPTH) ** 0.25
BETA = (8 * DEPTH) ** -0.25

OFF_U = GMLP_WIDTH
OFF_V = 2 * GMLP_WIDTH
OFF_Q = OFF_V + ATTN_WIDTH
OFF_K = OFF_Q + KV_WIDTH
OFF_VA = OFF_K + KV_WIDTH
OFF_GA = OFF_VA + D_MODEL
IN_WIDTH = OFF_GA + D_MODEL

kernel_name = "hybrid_gmlp_swa_sink_deepnorm_decoder"


def layer_norm(x, g, b):
    xf = x.astype(jnp.float32)
    mu = jnp.mean(xf, axis=-1, keepdims=True)
    var = jnp.mean(jnp.square(xf - mu), axis=-1, keepdims=True)
    y = (xf - mu) * lax.rsqrt(var + LN_EPS)
    return (y * g.astype(jnp.float32) + b.astype(jnp.float32)).astype(x.dtype)


def rope_tables(seq):
    inv = 1.0 / (ROPE_THETA ** (jnp.arange(0, HEAD_DIM, 2, dtype=jnp.float32) / HEAD_DIM))
    pos = jnp.arange(seq, dtype=jnp.float32)
    ang = pos[:, None] * inv[None, :]
    return jnp.cos(ang), jnp.sin(ang)


def apply_rope(x, cos, sin):
    xf = x.astype(jnp.float32)
    x1, x2 = jnp.split(xf, 2, axis=-1)
    c = cos[None, :, None, :]
    s = sin[None, :, None, :]
    return jnp.concatenate([x1 * c - x2 * s, x2 * c + x1 * s], axis=-1).astype(x.dtype)


def chunked_spatial_gating(u, v, ln_g, ln_b, w_s, b_s):
    bsz, seq, _ = u.shape
    n_chunks = seq // CHUNK
    v = layer_norm(v, ln_g, ln_b)
    vc = v.reshape(bsz, n_chunks, CHUNK, GMLP_GROUPS, GMLP_GROUP_DIM)
    causal = jnp.tril(jnp.ones((CHUNK, CHUNK), dtype=bool))
    w = jnp.where(causal[None], w_s, 0.0)
    mixed = jnp.einsum('gts,bnsgc->bntgc', w, vc) + b_s.T[None, None, :, :, None]
    return u * mixed.reshape(bsz, seq, GMLP_WIDTH)


def sliding_window_attention(q, k, v, sinks):
    bsz, seq, _, _ = q.shape
    n_blk = seq // WINDOW
    grp = N_Q_HEADS // N_KV_HEADS
    qb = q.reshape(bsz, n_blk, WINDOW, N_KV_HEADS, grp, HEAD_DIM)
    kb = k.reshape(bsz, n_blk, WINDOW, N_KV_HEADS, HEAD_DIM)
    vb = v.reshape(bsz, n_blk, WINDOW, N_KV_HEADS, HEAD_DIM)
    pad = ((0, 0), (1, 0), (0, 0), (0, 0), (0, 0))
    kk = jnp.concatenate([jnp.pad(kb, pad)[:, :-1], kb], axis=2)
    vv = jnp.concatenate([jnp.pad(vb, pad)[:, :-1], vb], axis=2)
    scores = jnp.einsum('bnqhgd,bnkhd->bnhgqk', qb, kk).astype(jnp.float32) * (HEAD_DIM ** -0.5)
    q_loc = jnp.arange(WINDOW)[:, None]
    k_loc = jnp.arange(2 * WINDOW)[None, :]
    band = (k_loc <= q_loc + WINDOW) & (k_loc > q_loc)
    blk = jnp.arange(n_blk)[:, None, None]
    valid = band[None] & (blk * WINDOW + k_loc[None] - WINDOW >= 0)
    scores = jnp.where(valid[None, :, None, None], scores, -jnp.inf)
    sink = sinks.astype(jnp.float32).reshape(N_KV_HEADS, grp)[None, None, :, :, None, None]
    m = jnp.maximum(jnp.max(scores, axis=-1, keepdims=True), sink)
    p = jnp.exp(scores - m)
    probs = (p / (jnp.sum(p, axis=-1, keepdims=True) + jnp.exp(sink - m))).astype(v.dtype)
    out = jnp.einsum('bnhgqk,bnkhd->bnqhgd', probs, vv)
    return out.reshape(bsz, seq, ATTN_WIDTH)


def hybrid_mixer(x, w_in, b_gate, ln_v_g, ln_v_b, w_s, b_s, sinks, w_br_a, w_br_b, w_o, cos, sin):
    bsz, seq, _ = x.shape
    proj = x @ w_in
    u, v, q, k, va, ga, gb = jnp.split(proj, [OFF_U, OFF_V, OFF_Q, OFF_K, OFF_VA, OFF_GA], axis=-1)
    ya = chunked_spatial_gating(jax.nn.gelu(u), jax.nn.gelu(v), ln_v_g, ln_v_b, w_s, b_s) @ w_br_a
    q = apply_rope(q.reshape(bsz, seq, N_Q_HEADS, HEAD_DIM), cos, sin)
    k = apply_rope(k.reshape(bsz, seq, N_KV_HEADS, HEAD_DIM), cos, sin)
    va = va.reshape(bsz, seq, N_KV_HEADS, HEAD_DIM)
    yb = sliding_window_attention(q, k, va, sinks) @ w_br_b
    merged = jax.nn.sigmoid(ga + b_gate[:D_MODEL]) * ya + jax.nn.sigmoid(gb + b_gate[D_MODEL:]) * yb
    return merged @ w_o


def memory_cross_attention(x, mem, w_xq, w_xkv, w_xo):
    bsz, seq, _ = x.shape
    q = (x @ w_xq).reshape(bsz, seq, X_HEADS, X_HEAD_DIM)
    k, v = jnp.split(mem @ w_xkv, 2, axis=-1)
    k = k.reshape(bsz, MEM_LEN, X_HEADS, X_HEAD_DIM)
    v = v.reshape(bsz, MEM_LEN, X_HEADS, X_HEAD_DIM)
    s = jnp.einsum('bqhd,bkhd->bhqk', q, k).astype(jnp.float32) * (X_HEAD_DIM ** -0.5)
    p = jax.nn.softmax(s, axis=-1).astype(v.dtype)
    o = jnp.einsum('bhqk,bkhd->bqhd', p, v).reshape(bsz, seq, X_WIDTH)
    return o @ w_xo


def squared_relu_mlp(x, w_up, w_down):
    return jnp.square(jax.nn.relu(x @ w_up)) @ w_down


def setup_inputs(seed: int = 0) -> dict:
    key = jax.random.key(seed)
    ks = jax.random.split(key, 26)
    f32 = jnp.float32
    L, D = DEPTH, D_MODEL

    def nrm(k, shape, scale):
        return jax.random.normal(k, shape, f32) * scale

    return {
        "x": nrm(ks[0], (BATCH, SEQ, D), 1.0),
        "mem": nrm(ks[1], (BATCH, MEM_LEN, D), 1.0),
        "w_in": nrm(ks[2], (L, D, IN_WIDTH), D ** -0.5),
        "b_gate": nrm(ks[3], (L, 2 * D), 0.1),
        "ln_v_g": 1.0 + nrm(ks[4], (L, GMLP_WIDTH), 0.02),
        "ln_v_b": nrm(ks[5], (L, GMLP_WIDTH), 0.02),
        "w_s": nrm(ks[6], (L, GMLP_GROUPS, CHUNK, CHUNK), 0.05),
        "b_s": 1.0 + nrm(ks[7], (L, GMLP_GROUPS, CHUNK), 0.1),
        "sinks": nrm(ks[8], (L, N_Q_HEADS), 0.5),
        "w_br_a": nrm(ks[9], (L, GMLP_WIDTH, D), GMLP_WIDTH ** -0.5),
        "w_br_b": nrm(ks[10], (L, ATTN_WIDTH, D), ATTN_WIDTH ** -0.5),
        "w_o": nrm(ks[11], (L, D, D), BETA * D ** -0.5),
        "ln1_g": 1.0 + nrm(ks[12], (L, D), 0.02),
        "ln1_b": nrm(ks[13], (L, D), 0.02),
        "w_xq": nrm(ks[14], (L, D, X_WIDTH), D ** -0.5),
        "w_xkv": nrm(ks[15], (L, D, 2 * X_WIDTH), D ** -0.5),
        "w_xo": nrm(ks[16], (L, X_WIDTH, D), BETA * X_WIDTH ** -0.5),
        "ln2_g": 1.0 + nrm(ks[17], (L, D), 0.02),
        "ln2_b": nrm(ks[18], (L, D), 0.02),
        "w_up": nrm(ks[19], (L, D, D_FF), D ** -0.5),
        "w_down": nrm(ks[20], (L, D_FF, D), BETA * D_FF ** -0.5),
        "ln3_g": 1.0 + nrm(ks[21], (L, D), 0.02),
        "ln3_b": nrm(ks[22], (L, D), 0.02),
    }


def reference(x, mem, w_in, b_gate, ln_v_g, ln_v_b, w_s, b_s, sinks, w_br_a, w_br_b, w_o,
              ln1_g, ln1_b, w_xq, w_xkv, w_xo, ln2_g, ln2_b, w_up, w_down, ln3_g, ln3_b):
    cos, sin = rope_tables(x.shape[1])
    for l in range(DEPTH):
        y = hybrid_mixer(x, w_in[l], b_gate[l], ln_v_g[l], ln_v_b[l], w_s[l], b_s[l], sinks[l],
                         w_br_a[l], w_br_b[l], w_o[l], cos, sin)
        x = layer_norm(ALPHA * x + y, ln1_g[l], ln1_b[l])
        y = memory_cross_attention(x, mem, w_xq[l], w_xkv[l], w_xo[l])
        x = layer_norm(ALPHA * x + y, ln2_g[l], ln2_b[l])
        y = squared_relu_mlp(x, w_up[l], w_down[l])
        x = layer_norm(ALPHA * x + y, ln3_g[l], ln3_b[l])
    return x
```

```cpp
#include <hip/hip_runtime.h>
#include <hip/hip_cooperative_groups.h>
#include <cstdio>
namespace cg = cooperative_groups;

#ifndef LAUNCH_PER_PHASE
#define LAUNCH_PER_PHASE 0
#endif

#define LAS __attribute__((address_space(3)))
typedef unsigned short bf16_t;
typedef short bf16x8 __attribute__((ext_vector_type(8)));
typedef float f32x4 __attribute__((ext_vector_type(4)));
typedef unsigned u32x4 __attribute__((ext_vector_type(4)));
typedef unsigned u32x2 __attribute__((ext_vector_type(2)));

constexpr int M = 16384, D = 2048, SEQ = 4096, NIN = 7680, GW = 1024, AW = 1024, KVW = 256, XW = 512, FF = 8192, MROWS = 1024, DEPTH = 2;
constexpr float ALPHA = 1.4142135623730951f, LN_EPS = 1e-5f;
constexpr int LDS_BYTES = 144384;
constexpr int RS_OFF = 131072, CV_OFF = 135168;
constexpr int NPH = 10;
constexpr int XCD_BAR_WORDS_C = 3456;

constexpr size_t WS_WIN = 0;
constexpr size_t WS_WBRA = WS_WIN + (size_t)NIN * D * 2;
constexpr size_t WS_WBRB = WS_WBRA + (size_t)D * GW * 2;
constexpr size_t WS_WO = WS_WBRB + (size_t)D * AW * 2;
constexpr size_t WS_WXQ = WS_WO + (size_t)D * D * 2;
constexpr size_t WS_WXKV = WS_WXQ + (size_t)XW * D * 2;
constexpr size_t WS_WXO = WS_WXKV + (size_t)2 * XW * D * 2;
constexpr size_t WS_WUP = WS_WXO + (size_t)D * XW * 2;
constexpr size_t WS_WDN = WS_WUP + (size_t)FF * D * 2;
constexpr size_t WS_XB = WS_WDN + (size_t)D * FF * 2;
constexpr size_t WS_R1 = WS_XB + (size_t)M * D * 2;
constexpr size_t R1_GU = 0, R1_GV = R1_GU + (size_t)M * GW * 2, R1_Q = R1_GV + (size_t)M * GW * 2, R1_K = R1_Q + (size_t)M * AW * 2,
                 R1_V = R1_K + (size_t)M * KVW * 2, R1_SA = R1_V + (size_t)M * KVW * 2, R1_SB = R1_SA + (size_t)M * D * 2;
constexpr size_t WS_R2 = WS_R1 + (size_t)M * FF * 2;
constexpr size_t WS_MEMB = WS_R2 + (size_t)M * D * 2;
constexpr size_t WS_XKV = WS_MEMB + (size_t)MROWS * D * 2;
constexpr size_t WS_ROPE = WS_XKV + (size_t)MROWS * 2 * XW * 2;
constexpr size_t WS_BAR = WS_ROPE + (size_t)SEQ * 32 * 2 * 4;
constexpr size_t WS_STATS = WS_BAR + (size_t)XCD_BAR_WORDS_C * 4;
constexpr size_t WS_STATSV = WS_STATS + (size_t)2 * M * 32 * 2 * 4;
constexpr size_t WS_CS = WS_STATSV + (size_t)M * 16 * 2 * 4;
constexpr size_t CS_IN = 0, CS_XQ = CS_IN + (size_t)8 * NIN, CS_UP = CS_XQ + (size_t)8 * XW, CS_END_F = CS_UP + (size_t)8 * FF;
constexpr size_t WS_END = WS_CS + CS_END_F * 4;

struct Params {
    const float* in[23];
    float* out;
    unsigned char* ws;
    int ph_lo, ph_hi;
};

__device__ __forceinline__ unsigned cvt_pk_bf16(float lo, float hi) { unsigned r; asm volatile("v_cvt_pk_bf16_f32 %0, %1, %2" : "=v"(r) : "v"(lo), "v"(hi)); return r; }
__device__ __forceinline__ float bf_lo(unsigned w) { return __uint_as_float(w << 16); }
__device__ __forceinline__ float bf_hi(unsigned w) { return __uint_as_float(w & 0xffff0000u); }
__device__ __forceinline__ float bf2f(bf16_t b) { return __uint_as_float(((unsigned)b) << 16); }
__device__ __forceinline__ bf16_t f2bf(float f) { return (bf16_t)(cvt_pk_bf16(f, 0.f) & 0xffffu); }
__device__ __forceinline__ float gelu_tanh(float x) { const float u = x * (-2.302208198f - 0.1029432397f * x * x); return x * __builtin_amdgcn_rcpf(1.f + __builtin_amdgcn_exp2f(u)); }
__device__ __forceinline__ float sigmoidf_(float x) { return __builtin_amdgcn_rcpf(1.f + __builtin_amdgcn_exp2f(-1.4426950408889634f * x)); }
__device__ __forceinline__ float shflx(float v, int k, int lane) { return __int_as_float(__builtin_amdgcn_ds_bpermute((lane ^ k) << 2, __float_as_int(v))); }
__device__ __forceinline__ float wave_sum(float v, int lane) { for (int o = 32; o >= 1; o >>= 1) v += shflx(v, o, lane); return v; }

namespace pg8 {
constexpr int BM = 256, BK = 64, HALF = 128, HTB = HALF * BK * 2, STAGE_BYTES = 8 * HTB, NXCD = 8, WGM = 4;
constexpr bool SP2 = true;
constexpr bool ALIGN_EPI = true;
__host__ __device__ __forceinline__ int lds_byte(int r, int c) { const int st = (r >> 4) * 2 + (c >> 5), rr = r & 15, cc = c & 31, ob = rr * 64 + cc * 2; return st * 1024 + (ob ^ (((ob >> 9) & 1) << 5)); }
__host__ __device__ __forceinline__ void stage_rc(int b, int& R, int& C) { const int st = b / 1024, sb = b % 1024, swz = sb ^ (((sb >> 9) & 1) << 5); R = (st >> 1) * 16 + swz / 64; C = (st & 1) * 32 + (swz % 64) / 2; }
__host__ __device__ __forceinline__ int perm32(int rho) { const int n = rho >> 4, i = rho & 15; return 8 * (i >> 2) + 4 * n + (i & 3); }
struct Unit { int pm, pn; };
struct Gemm { const bf16_t* A; const bf16_t* Bt; int M, N, K; const bf16_t* A2; const bf16_t* Bt2; };
struct StaticOrder {
    int nM, nN, nwg, G, c, rev;
    __device__ void init(int M_, int N_, int G_, int c_, int rev_ = 0) { nM = M_ / BM; nN = N_ / BM; nwg = nM * nN; G = G_; c = c_; rev = rev_; }
    __device__ bool next(int i, Unit& u) const {
        const int nr = (nwg + G - 1) / G; if (i >= nr) return false;
        const long L = (long)(rev ? nr - 1 - i : i) * G + c; if (L >= nwg) return false;
        int wgid = (int)L; { const int q = nwg / NXCD, r = nwg % NXCD, xcd = wgid % NXCD, off = wgid / NXCD; wgid = (xcd < r ? xcd * (q + 1) : r * (q + 1) + (xcd - r) * q) + off; }
        const int nig = WGM * nN, gid = wgid / nig, fm = gid * WGM, gsz = (nM - fm) < WGM ? (nM - fm) : WGM;
        u.pm = fm + ((wgid % nig) % gsz); u.pn = (wgid % nig) / gsz; return true;
    }
};

template <class Epi>
__device__ __forceinline__ void gemm_phase(LAS unsigned char* lds, const Gemm g, const StaticOrder& S, const Epi& E, const int tid) {
    const int wid = __builtin_amdgcn_readfirstlane(tid >> 6), lane = tid & 63, wr = wid >> 2, wc = wid & 3, fr = lane & 15, fq = lane >> 4;
    const int K = g.K, nt = K / BK, ntt = Epi::TWO ? 2 * nt : nt;
    unsigned voffA[2], voffB[2];
#pragma unroll
    for (int i = 0; i < 2; ++i) { int R, C; stage_rc(tid * 16 + i * 8192, R, C); const int Rb = (R >> 5) * 64 + ((R >> 2) & 3) * 16 + ((R >> 4) & 1) * 4 + (R & 3);
        voffA[i] = (unsigned)(R * K + C) * 2u; voffB[i] = (unsigned)(Rb * K + C) * 2u; }
    const size_t kstep = (size_t)(BK * 2);
    const size_t hstep = (size_t)HALF * K * 2;
    const size_t tstep = 2 * hstep;
    const size_t bhs = (size_t)8 * K * 2;
    const unsigned ldsw = (unsigned)wid * 1024u;
    const int aoff = lds_byte(wr * 64 + fr, fq * 8), boff = lds_byte(wc * 32 + fr, fq * 8);
#define PG8_SA(b, h) (((b) * 2 + (h)) * HTB)
#define PG8_SB(b, h) ((4 + (b) * 2 + (h)) * HTB)
#define PG8_STAGE(bufoff, gbase, voff) do { _Pragma("unroll") for (int _i = 0; _i < 2; ++_i) \
        __builtin_amdgcn_global_load_lds((const unsigned*)((const char*)(gbase) + (voff)[_i]), (LAS unsigned*)(lds + (bufoff) + ldsw + _i * 8192), 16, 0, 0); } while (0)
#define PG8_LDA(dst, b, h) do { _Pragma("unroll") for (int m = 0; m < 4; ++m) _Pragma("unroll") for (int k = 0; k < 2; ++k) dst[m][k] = *(const LAS bf16x8*)(lds + PG8_SA(b, h) + aoff + m * 2048 + k * 1024); } while (0)
#define PG8_LDB(dst, b, h) do { _Pragma("unroll") for (int n = 0; n < 2; ++n) _Pragma("unroll") for (int k = 0; k < 2; ++k) dst[n][k] = *(const LAS bf16x8*)(lds + PG8_SB(b, h) + boff + n * 2048 + k * 1024); } while (0)
#define PG8_MMA(ai, bj, At, Bt) do { __builtin_amdgcn_s_setprio(1); _Pragma("unroll") for (int m = 0; m < 4; ++m) _Pragma("unroll") for (int n = 0; n < 2; ++n) _Pragma("unroll") for (int k = 0; k < 2; ++k) \
        acc[ai][bj][m][n] = __builtin_amdgcn_mfma_f32_16x16x32_bf16(Bt[n][k], At[m][k], acc[ai][bj][m][n], 0, 0, 0); __builtin_amdgcn_s_setprio(0); } while (0)
#define PG8_WAIT_V(n) asm volatile("s_waitcnt vmcnt(" #n ")" ::: "memory")
#define PG8_WAIT_L(n) asm volatile("s_waitcnt lgkmcnt(" #n ")" ::: "memory")
#define PG8_BAR __builtin_amdgcn_s_barrier()
#define PG8_SCHED __builtin_amdgcn_sched_barrier(0)
    Unit cur, nxt; int ui = 0;
    if (!S.next(0, cur)) return;
    E.prepare(cur, lds, 0, tid);
    f32x4 acc[2][2][4][2];
#pragma unroll
    for (int a = 0; a < 2; ++a)
#pragma unroll
        for (int b = 0; b < 2; ++b)
#pragma unroll
            for (int m = 0; m < 4; ++m)
#pragma unroll
                for (int n = 0; n < 2; ++n) acc[a][b][m][n] = (f32x4){0.f, 0.f, 0.f, 0.f};
    bf16x8 At[4][2], B0[2][2], B1[2][2];
    const char* cA = (const char*)g.A + (size_t)cur.pm * tstep; const char* cB = (const char*)g.Bt + (size_t)cur.pn * tstep;
    const char* cA2 = Epi::TWO ? (const char*)g.A2 + (size_t)cur.pm * tstep : cA; const char* cB2 = Epi::TWO ? (const char*)g.Bt2 + (size_t)cur.pn * tstep : cB;
    if constexpr (SP2) {
        PG8_STAGE(PG8_SB(0, 0), cB, voffB); PG8_STAGE(PG8_SB(0, 1), cB + bhs, voffB); PG8_STAGE(PG8_SA(0, 0), cA, voffA); PG8_STAGE(PG8_SA(0, 1), cA + hstep, voffA);
        if (wr == 1) PG8_BAR;
        PG8_WAIT_V(2); PG8_BAR;
        PG8_STAGE(PG8_SB(1, 0), cB + kstep, voffB); PG8_STAGE(PG8_SA(1, 0), cA + kstep, voffA); PG8_STAGE(PG8_SB(1, 1), cB + bhs + kstep, voffB);
        PG8_WAIT_V(6); PG8_BAR;
    } else {
        PG8_STAGE(PG8_SB(0, 0), cB, voffB); PG8_STAGE(PG8_SA(0, 0), cA, voffA); PG8_STAGE(PG8_SB(0, 1), cB + bhs, voffB); PG8_STAGE(PG8_SA(0, 1), cA + hstep, voffA);
        if (wr == 1) PG8_BAR;
        PG8_WAIT_V(4); PG8_BAR;
        PG8_STAGE(PG8_SB(1, 0), cB + kstep, voffB); PG8_STAGE(PG8_SA(1, 0), cA + kstep, voffA); PG8_STAGE(PG8_SB(1, 1), cB + bhs + kstep, voffB);
        PG8_WAIT_V(6); PG8_BAR;
    }
    for (;;) {
        const bool has_next = S.next(ui + 1, nxt);
        const char* nA = has_next ? (const char*)g.A + (size_t)nxt.pm * tstep : cA; const char* nB = has_next ? (const char*)g.Bt + (size_t)nxt.pn * tstep : cB;
        for (int t = 0; t < ntt; t += 2) {
            const bool last = (t == ntt - 2);
            const bool s1 = Epi::TWO && (t >= nt), s2 = Epi::TWO && (t + 2 >= nt);
            const char* a1 = (s1 ? cA2 + (size_t)(t - nt + 1) * kstep : cA + (size_t)(t + 1) * kstep);
            const char* a2 = last ? nA : (s2 ? cA2 + (size_t)(t + 2 - nt) * kstep : cA + (size_t)(t + 2) * kstep);
            const char* b2 = last ? nB : (s2 ? cB2 + (size_t)(t + 2 - nt) * kstep : cB + (size_t)(t + 2) * kstep);
            const char* a3 = a2 + kstep; const char* b3 = b2 + kstep;
            if constexpr (Epi::TWO) { if (t == nt) E.mid(acc, cur, wr, wc, fr, fq); }
            if constexpr (SP2) {
            PG8_LDB(B0, 0, 0); PG8_LDB(B1, 0, 1); PG8_SCHED; PG8_LDA(At, 0, 0); PG8_STAGE(PG8_SA(1, 1), a1 + hstep, voffA);
            PG8_WAIT_V(8); PG8_WAIT_L(0); PG8_BAR; PG8_MMA(0, 0, At, B0); PG8_MMA(0, 1, At, B1); PG8_BAR; PG8_SCHED;
            PG8_LDA(At, 0, 1); PG8_STAGE(PG8_SB(0, 0), b2, voffB); PG8_STAGE(PG8_SB(0, 1), b2 + bhs, voffB); PG8_STAGE(PG8_SA(0, 0), a2, voffA);
            PG8_WAIT_V(8); PG8_WAIT_L(0); PG8_BAR; PG8_MMA(1, 0, At, B0); PG8_MMA(1, 1, At, B1); PG8_BAR; PG8_SCHED;
            PG8_LDB(B0, 1, 0); PG8_LDB(B1, 1, 1); PG8_SCHED; PG8_LDA(At, 1, 0); PG8_STAGE(PG8_SA(0, 1), a2 + hstep, voffA);
            PG8_WAIT_V(8); PG8_WAIT_L(0); PG8_BAR; PG8_MMA(0, 0, At, B0); PG8_MMA(0, 1, At, B1); PG8_BAR; PG8_SCHED;
            PG8_LDA(At, 1, 1); PG8_STAGE(PG8_SB(1, 0), b3, voffB); PG8_STAGE(PG8_SB(1, 1), b3 + bhs, voffB); PG8_STAGE(PG8_SA(1, 0), a3, voffA);
            PG8_WAIT_V(8); PG8_WAIT_L(0); PG8_BAR; PG8_MMA(1, 0, At, B0); PG8_MMA(1, 1, At, B1); PG8_BAR; PG8_SCHED;
            } else {
            PG8_LDB(B0, 0, 0); PG8_SCHED; PG8_LDA(At, 0, 0); PG8_STAGE(PG8_SA(1, 1), a1 + hstep, voffA);
            PG8_WAIT_L(8); PG8_BAR; PG8_WAIT_L(0); PG8_MMA(0, 0, At, B0); PG8_BAR; PG8_SCHED;
            PG8_LDB(B1, 0, 1); PG8_STAGE(PG8_SB(0, 0), b2, voffB);
            PG8_BAR; PG8_WAIT_L(0); PG8_MMA(0, 1, At, B1); PG8_BAR;
            PG8_LDA(At, 0, 1); PG8_STAGE(PG8_SA(0, 0), a2, voffA);
            PG8_BAR; PG8_WAIT_L(0); PG8_MMA(1, 0, At, B0); PG8_BAR; PG8_SCHED;
            PG8_STAGE(PG8_SB(0, 1), b2 + bhs, voffB);
            PG8_WAIT_V(6); PG8_BAR; PG8_MMA(1, 1, At, B1); PG8_BAR;
            PG8_LDB(B0, 1, 0); PG8_SCHED; PG8_LDA(At, 1, 0); PG8_STAGE(PG8_SA(0, 1), a2 + hstep, voffA);
            PG8_WAIT_L(8); PG8_BAR; PG8_WAIT_L(0); PG8_MMA(0, 0, At, B0); PG8_BAR; PG8_SCHED;
            PG8_LDB(B1, 1, 1); PG8_STAGE(PG8_SB(1, 0), b3, voffB);
            PG8_BAR; PG8_WAIT_L(0); PG8_MMA(0, 1, At, B1); PG8_BAR;
            PG8_LDA(At, 1, 1); PG8_STAGE(PG8_SA(1, 0), a3, voffA);
            PG8_BAR; PG8_WAIT_L(0); PG8_MMA(1, 0, At, B0); PG8_BAR; PG8_SCHED;
            PG8_STAGE(PG8_SB(1, 1), b3 + bhs, voffB);
            PG8_WAIT_V(6); PG8_BAR; PG8_MMA(1, 1, At, B1); PG8_BAR;
            }
        }
        if (ALIGN_EPI) { if (wr == 0) PG8_BAR; }
        E(acc, cur, wr, wc, fr, fq, lds, ui & 1);
        if (!has_next) break;
#pragma unroll
        for (int a = 0; a < 2; ++a)
#pragma unroll
            for (int b = 0; b < 2; ++b)
#pragma unroll
                for (int m = 0; m < 4; ++m)
#pragma unroll
                    for (int n = 0; n < 2; ++n) acc[a][b][m][n] = (f32x4){0.f, 0.f, 0.f, 0.f};
        cur = nxt; cA = nA; cB = nB; ++ui;
        if (Epi::TWO) { cA2 = (const char*)g.A2 + (size_t)cur.pm * tstep; cB2 = (const char*)g.Bt2 + (size_t)cur.pn * tstep; }
        E.prepare(cur, lds, ui & 1, tid);
        if (ALIGN_EPI) { if (wr == 1) PG8_BAR; }
    }
    PG8_WAIT_V(0);
    if (!ALIGN_EPI) { if (wr == 0) PG8_BAR; }
    PG8_BAR;
#undef PG8_SA
#undef PG8_SB
#undef PG8_STAGE
#undef PG8_LDA
#undef PG8_LDB
#undef PG8_MMA
#undef PG8_WAIT_V
#undef PG8_WAIT_L
#undef PG8_BAR
#undef PG8_SCHED
}
}

__device__ __forceinline__ u32x4 pack8(const f32x4 a, const f32x4 b) { u32x4 w; w.x = cvt_pk_bf16(a[0], a[1]); w.y = cvt_pk_bf16(a[2], a[3]); w.z = cvt_pk_bf16(b[0], b[1]); w.w = cvt_pk_bf16(b[2], b[3]); return w; }


struct Fold {
    const float* stats;
    const float* cs;
    int N;
    __device__ __forceinline__ void prepare(const pg8::Unit& u, LAS unsigned char* lds, int par, int tid) const {
        if (stats == nullptr) return;
        const int h = tid >> 8, tt = tid & 255, rl = tt >> 1, part = tt & 1, lrow = (rl >> 6) * 128 + h * 64 + (rl & 63);
        const float* sp = stats + ((size_t)(u.pm * 256 + lrow) * 32 + part * 16) * 2;
        float s1 = 0.f, s2 = 0.f;
#pragma unroll
        for (int i = 0; i < 8; ++i) { const f32x4 v = *(const f32x4*)(sp + 4 * i); s1 += v[0] + v[2]; s2 += v[1] + v[3]; }
        s1 += shflx(s1, 1, tid & 63); s2 += shflx(s2, 1, tid & 63);
        const float mu = s1 * (1.f / D), var = s2 * (1.f / D) - mu * mu, rstd = __builtin_amdgcn_rsqf(var + LN_EPS);
        if (part == 0) { LAS float* rs = (LAS float*)(lds + RS_OFF) + (par * 256 + lrow) * 2; rs[0] = mu; rs[1] = rstd; }
        if (cs != nullptr) {
            const int col = u.pn * 256 + tt;
            const float c = (cs[col] + cs[N + col]) + (cs[2 * N + col] + cs[3 * N + col]);
            const float b = (cs[4 * N + col] + cs[5 * N + col]) + (cs[6 * N + col] + cs[7 * N + col]);
            LAS float* cv = (LAS float*)(lds + CV_OFF) + ((par * 2 + h) * 256 + tt) * 2; cv[0] = c; cv[1] = b;
        }
    }
};
__device__ __forceinline__ void fold_apply(f32x4& v0, f32x4& v1, float mu, float rstd, const LAS float* cv, int lc) {
    const f32x4 c0 = *(const LAS f32x4*)(cv + 2 * lc), c1 = *(const LAS f32x4*)(cv + 2 * lc + 4), c2 = *(const LAS f32x4*)(cv + 2 * lc + 8), c3 = *(const LAS f32x4*)(cv + 2 * lc + 12);
    const float rm = rstd * mu;
    v0[0] = rstd * v0[0] - rm * c0[0] + c0[1]; v0[1] = rstd * v0[1] - rm * c0[2] + c0[3]; v0[2] = rstd * v0[2] - rm * c1[0] + c1[1]; v0[3] = rstd * v0[3] - rm * c1[2] + c1[3];
    v1[0] = rstd * v1[0] - rm * c2[0] + c2[1]; v1[1] = rstd * v1[1] - rm * c2[2] + c2[3]; v1[2] = rstd * v1[2] - rm * c3[0] + c3[1]; v1[3] = rstd * v1[3] - rm * c3[2] + c3[3];
}

struct EpiIn {
    static constexpr bool PERM = true, TWO = false;
    bf16_t *gu, *gv, *q, *kb, *vb, *sa, *sb; const float* bgate; const float* rope; float* statsv; Fold F;
    __device__ __forceinline__ void prepare(const pg8::Unit& u, LAS unsigned char* lds, int par, int tid) const { F.prepare(u, lds, par, tid); }
    __device__ __forceinline__ void operator()(const f32x4 (&acc)[2][2][4][2], const pg8::Unit& u, int wr, int wc, int fr, int fq, LAS unsigned char* lds, int par) const {
        const bool fold = F.stats != nullptr;
        const LAS float* rsb = (const LAS float*)(lds + RS_OFF) + par * 512; const LAS float* cvb = (const LAS float*)(lds + CV_OFF) + (par * 2 + wr) * 512;
        const int pn = u.pn, row0 = u.pm * 256 + wr * 64 + fr, cl = wc * 64 + 16 * fq;
        int kind, ld, ct; bf16_t* base;
        if (pn < 4) { kind = 0; base = gu; ld = GW; ct = pn * 256; }
        else if (pn < 8) { kind = 0; base = gv; ld = GW; ct = (pn - 4) * 256; }
        else if (pn < 12) { kind = 1; base = q; ld = AW; ct = (pn - 8) * 256; }
        else if (pn == 12) { kind = 2; base = kb; ld = KVW; ct = 0; }
        else if (pn == 13) { kind = 3; base = vb; ld = KVW; ct = 0; }
        else if (pn < 22) { kind = 4; base = sa; ld = D; ct = (pn - 14) * 256; }
        else { kind = 4; base = sb; ld = D; ct = (pn - 22) * 256; }
        const int gcol = (pn - 14) * 256;
#pragma unroll
        for (int ai = 0; ai < 2; ++ai)
#pragma unroll
            for (int m = 0; m < 4; ++m) {
                const int row = row0 + ai * 128 + m * 16, lrow = ai * 128 + wr * 64 + m * 16 + fr;
                float mu = 0.f, rstd = 1.f; if (fold) { mu = rsb[2 * lrow]; rstd = rsb[2 * lrow + 1]; }
                float s1 = 0.f, s2 = 0.f;
#pragma unroll
                for (int bj = 0; bj < 2; ++bj) {
                    const int c = cl + bj * 8;
                    f32x4 v0 = acc[ai][bj][m][0], v1 = acc[ai][bj][m][1];
                    if (fold) fold_apply(v0, v1, mu, rstd, cvb, c);
                    if (kind == 0) {
#pragma unroll
                        for (int j = 0; j < 4; ++j) { v0[j] = gelu_tanh(v0[j]); v1[j] = gelu_tanh(v1[j]); }
                    } else if (kind == 1 || kind == 2) {
                        const int pos = row & (SEQ - 1), i0 = (c & 63) >> 1;
                        const f32x4 r0 = *(const f32x4*)(rope + ((size_t)pos * 32 + i0) * 2), r1 = *(const f32x4*)(rope + ((size_t)pos * 32 + i0 + 2) * 2);
                        const float sc = (kind == 1) ? 0.125f : 1.0f;
                        f32x4 o0, o1;
                        o0[0] = (v0[0] * r0[0] - v0[1] * r0[1]) * sc; o0[1] = (v0[1] * r0[0] + v0[0] * r0[1]) * sc;
                        o0[2] = (v0[2] * r0[2] - v0[3] * r0[3]) * sc; o0[3] = (v0[3] * r0[2] + v0[2] * r0[3]) * sc;
                        o1[0] = (v1[0] * r1[0] - v1[1] * r1[1]) * sc; o1[1] = (v1[1] * r1[0] + v1[0] * r1[1]) * sc;
                        o1[2] = (v1[2] * r1[2] - v1[3] * r1[3]) * sc; o1[3] = (v1[3] * r1[2] + v1[2] * r1[3]) * sc;
                        v0 = o0; v1 = o1;
                    } else if (kind == 4) {
                        const f32x4 b0 = *(const f32x4*)(bgate + gcol + c), b1 = *(const f32x4*)(bgate + gcol + c + 4);
#pragma unroll
                        for (int j = 0; j < 4; ++j) { v0[j] = sigmoidf_(v0[j] + b0[j]); v1[j] = sigmoidf_(v1[j] + b1[j]); }
                    }
                    const u32x4 pw = pack8(v0, v1);
                    *(u32x4*)(base + (size_t)row * ld + ct + c) = pw;
                    if (kind == 0 && pn >= 4) {
                        const float a0 = bf_lo(pw.x), a1 = bf_hi(pw.x), a2 = bf_lo(pw.y), a3 = bf_hi(pw.y), a4 = bf_lo(pw.z), a5 = bf_hi(pw.z), a6 = bf_lo(pw.w), a7 = bf_hi(pw.w);
                        s1 += ((a0 + a1) + (a2 + a3)) + ((a4 + a5) + (a6 + a7));
                        s2 += ((a0 * a0 + a1 * a1) + (a2 * a2 + a3 * a3)) + ((a4 * a4 + a5 * a5) + (a6 * a6 + a7 * a7));
                    }
                }
                if (kind == 0 && pn >= 4) {
                    s1 += shflx(s1, 16, fr + 16 * fq); s1 += shflx(s1, 32, fr + 16 * fq); s2 += shflx(s2, 16, fr + 16 * fq); s2 += shflx(s2, 32, fr + 16 * fq);
                    if (fq == 0) { float* sp = statsv + ((size_t)row * 16 + (pn - 4) * 4 + wc) * 2; sp[0] = s1; sp[1] = s2; }
                }
            }
    }
};
template <int MODE> struct EpiB {
    static constexpr bool PERM = true, TWO = false;
    bf16_t* o; int ld; float scale; const bf16_t* gate; Fold F;
    __device__ __forceinline__ void prepare(const pg8::Unit& u, LAS unsigned char* lds, int par, int tid) const { F.prepare(u, lds, par, tid); }
    __device__ __forceinline__ void operator()(const f32x4 (&acc)[2][2][4][2], const pg8::Unit& u, int wr, int wc, int fr, int fq, LAS unsigned char* lds, int par) const {
        const bool fold = F.stats != nullptr;
        const LAS float* rsb = (const LAS float*)(lds + RS_OFF) + par * 512; const LAS float* cvb = (const LAS float*)(lds + CV_OFF) + (par * 2 + wr) * 512;
        const int row0 = u.pm * 256 + wr * 64 + fr, c0 = u.pn * 256 + wc * 64 + 16 * fq;
#pragma unroll
        for (int ai = 0; ai < 2; ++ai)
#pragma unroll
            for (int m = 0; m < 4; ++m) {
                const int row = row0 + ai * 128 + m * 16, lrow = ai * 128 + wr * 64 + m * 16 + fr;
                float mu = 0.f, rstd = 1.f; if (fold) { mu = rsb[2 * lrow]; rstd = rsb[2 * lrow + 1]; }
#pragma unroll
                for (int bj = 0; bj < 2; ++bj) {
                    const size_t off = (size_t)row * ld + c0 + bj * 8;
                    f32x4 v0 = acc[ai][bj][m][0], v1 = acc[ai][bj][m][1];
                    if (fold) fold_apply(v0, v1, mu, rstd, cvb, wc * 64 + 16 * fq + bj * 8);
                    if (MODE == 0) { v0 *= scale; v1 *= scale; }
                    if (MODE == 1) {
#pragma unroll
                        for (int j = 0; j < 4; ++j) { const float a = fmaxf(v0[j], 0.f), b = fmaxf(v1[j], 0.f); v0[j] = a * a; v1[j] = b * b; }
                    }
                    if (MODE == 2 || MODE == 3) {
                        const u32x4 gw = *(const u32x4*)(gate + off);
                        v0[0] *= bf_lo(gw.x); v0[1] *= bf_hi(gw.x); v0[2] *= bf_lo(gw.y); v0[3] *= bf_hi(gw.y);
                        v1[0] *= bf_lo(gw.z); v1[1] *= bf_hi(gw.z); v1[2] *= bf_lo(gw.w); v1[3] *= bf_hi(gw.w);
                    }
                    if (MODE == 3) {
                        const u32x4 pw = *(const u32x4*)(o + off);
                        v0[0] += bf_lo(pw.x); v0[1] += bf_hi(pw.x); v0[2] += bf_lo(pw.y); v0[3] += bf_hi(pw.y);
                        v1[0] += bf_lo(pw.z); v1[1] += bf_hi(pw.z); v1[2] += bf_lo(pw.w); v1[3] += bf_hi(pw.w);
                    }
                    *(u32x4*)(o + off) = pack8(v0, v1);
                }
            }
    }
};
struct EpiBR {
    static constexpr bool PERM = true, TWO = true;
    bf16_t* o; const bf16_t* sa; const bf16_t* sb;
    __device__ __forceinline__ void prepare(const pg8::Unit&, LAS unsigned char*, int, int) const {}
    __device__ __forceinline__ void mid(f32x4 (&acc)[2][2][4][2], const pg8::Unit& u, int wr, int wc, int fr, int fq) const {
        int row0 = u.pm * 256 + wr * 64 + fr, c0 = u.pn * 256 + wc * 64 + 16 * fq;
        asm volatile("" : "+v"(row0), "+v"(c0));
#pragma unroll
        for (int ai = 0; ai < 2; ++ai)
#pragma unroll
            for (int m = 0; m < 4; ++m)
#pragma unroll
                for (int bj = 0; bj < 2; ++bj) {
                    const size_t off = (size_t)(row0 + ai * 128 + m * 16) * D + c0 + bj * 8;
                    const u32x4 a = *(const u32x4*)(sa + off), b = *(const u32x4*)(sb + off);
                    f32x4 r0, r1;
                    r0[0] = bf_lo(a.x) * __builtin_amdgcn_rcpf(bf_lo(b.x)); r0[1] = bf_hi(a.x) * __builtin_amdgcn_rcpf(bf_hi(b.x)); r0[2] = bf_lo(a.y) * __builtin_amdgcn_rcpf(bf_lo(b.y)); r0[3] = bf_hi(a.y) * __builtin_amdgcn_rcpf(bf_hi(b.y));
                    r1[0] = bf_lo(a.z) * __builtin_amdgcn_rcpf(bf_lo(b.z)); r1[1] = bf_hi(a.z) * __builtin_amdgcn_rcpf(bf_hi(b.z)); r1[2] = bf_lo(a.w) * __builtin_amdgcn_rcpf(bf_lo(b.w)); r1[3] = bf_hi(a.w) * __builtin_amdgcn_rcpf(bf_hi(b.w));
                    acc[ai][bj][m][0] *= r0; acc[ai][bj][m][1] *= r1;
                    if ((m & 1) && bj == 1) asm volatile("" ::: "memory");
                }
    }
    __device__ __forceinline__ void operator()(const f32x4 (&acc)[2][2][4][2], const pg8::Unit& u, int wr, int wc, int fr, int fq, LAS unsigned char*, int) const {
        const int row0 = u.pm * 256 + wr * 64 + fr, c0 = u.pn * 256 + wc * 64 + 16 * fq;
#pragma unroll
        for (int ai = 0; ai < 2; ++ai)
#pragma unroll
            for (int m = 0; m < 4; ++m)
#pragma unroll
                for (int bj = 0; bj < 2; ++bj) {
                    const size_t off = (size_t)(row0 + ai * 128 + m * 16) * D + c0 + bj * 8;
                    const u32x4 b = *(const u32x4*)(sb + off);
                    f32x4 v0 = acc[ai][bj][m][0], v1 = acc[ai][bj][m][1];
                    v0[0] *= bf_lo(b.x); v0[1] *= bf_hi(b.x); v0[2] *= bf_lo(b.y); v0[3] *= bf_hi(b.y);
                    v1[0] *= bf_lo(b.z); v1[1] *= bf_hi(b.z); v1[2] *= bf_lo(b.w); v1[3] *= bf_hi(b.w);
                    *(u32x4*)(o + off) = pack8(v0, v1);
                }
    }
};
struct EpiRes {
    static constexpr bool PERM = true, TWO = false;
    const float* xin; float* xout; bf16_t* tb; const float* pg; const float* pb; float* stats_out; Fold F;
    __device__ __forceinline__ void prepare(const pg8::Unit& u, LAS unsigned char* lds, int par, int tid) const { F.prepare(u, lds, par, tid); }
    __device__ __forceinline__ void operator()(const f32x4 (&acc)[2][2][4][2], const pg8::Unit& u, int wr, int wc, int fr, int fq, LAS unsigned char* lds, int par) const {
        const bool prev = F.stats != nullptr;
        const LAS float* rsb = (const LAS float*)(lds + RS_OFF) + par * 512;
        const int row0 = u.pm * 256 + wr * 64 + fr, c0 = u.pn * 256 + wc * 64 + 16 * fq;
        f32x4 gg[4], bb[4];
        if (prev) {
#pragma unroll
            for (int i = 0; i < 4; ++i) { gg[i] = *(const f32x4*)(pg + c0 + 4 * i); bb[i] = *(const f32x4*)(pb + c0 + 4 * i); }
        }
#pragma unroll
        for (int ai = 0; ai < 2; ++ai)
#pragma unroll
            for (int m = 0; m < 4; ++m) {
                const int row = row0 + ai * 128 + m * 16, lrow = ai * 128 + wr * 64 + m * 16 + fr;
                const size_t ro = (size_t)row * D + c0;
                float mu = 0.f, rstd = 1.f; if (prev) { mu = rsb[2 * lrow]; rstd = rsb[2 * lrow + 1]; }
                float s1 = 0.f, s2 = 0.f;
#pragma unroll
                for (int bj = 0; bj < 2; ++bj) {
                    f32x4 r0, r1;
                    if (prev) {
                        const u32x4 w = *(const u32x4*)(tb + ro + bj * 8);
                        r0 = (f32x4){bf_lo(w.x), bf_hi(w.x), bf_lo(w.y), bf_hi(w.y)}; r1 = (f32x4){bf_lo(w.z), bf_hi(w.z), bf_lo(w.w), bf_hi(w.w)};
                        r0 = (r0 - mu) * rstd * gg[2 * bj] + bb[2 * bj]; r1 = (r1 - mu) * rstd * gg[2 * bj + 1] + bb[2 * bj + 1];
                    } else { r0 = *(const f32x4*)(xin + ro + bj * 8); r1 = *(const f32x4*)(xin + ro + bj * 8 + 4); }
                    const f32x4 t0 = r0 * ALPHA + acc[ai][bj][m][0], t1 = r1 * ALPHA + acc[ai][bj][m][1];
                    if (xout != nullptr) { *(f32x4*)(xout + ro + bj * 8) = t0; *(f32x4*)(xout + ro + bj * 8 + 4) = t1; }
                    const u32x4 pw = pack8(t0, t1);
                    *(u32x4*)(tb + ro + bj * 8) = pw;
                    const float a0 = bf_lo(pw.x), a1 = bf_hi(pw.x), a2 = bf_lo(pw.y), a3 = bf_hi(pw.y), a4 = bf_lo(pw.z), a5 = bf_hi(pw.z), a6 = bf_lo(pw.w), a7 = bf_hi(pw.w);
                    s1 += ((a0 + a1) + (a2 + a3)) + ((a4 + a5) + (a6 + a7));
                    s2 += ((a0 * a0 + a1 * a1) + (a2 * a2 + a3 * a3)) + ((a4 * a4 + a5 * a5) + (a6 * a6 + a7 * a7));
                }
                s1 += shflx(s1, 16, fr + 16 * fq); s1 += shflx(s1, 32, fr + 16 * fq); s2 += shflx(s2, 16, fr + 16 * fq); s2 += shflx(s2, 32, fr + 16 * fq);
                if (fq == 0) { float* sp = stats_out + ((size_t)row * 32 + u.pn * 4 + wc) * 2; sp[0] = s1; sp[1] = s2; }
            }
    }
};

template <bool FOLD>
__device__ __forceinline__ void conv_wt_t(const float* __restrict__ W, bf16_t* __restrict__ Wt, int K, int N, bool ropeperm, const float* __restrict__ gvec, const float* __restrict__ bvec,
                                          float* __restrict__ csP, LAS float* lds_f, const int tid, const int vbid, const int vG) {
    constexpr int TP = 257, TILE_F = 64 * TP + 60;
    if (vbid < 0) return;
    const int G = vG, bid = vbid, ntk = K >> 6, nt_all = ntk * (N >> 8), nunits = (N >> 8) * 4, u0 = vbid;
    const int lk = tid >> 6, ln4 = (tid & 63) << 2, n = tid >> 1, par = tid & 1;
    float csum = 0.f, bsum = 0.f;
#define CW_COORD(j, valid, k0, n0) do { if (FOLD) { const int _u = u0 + ((j) >> 3) * G; valid = _u < nunits; n0 = (_u >> 2) << 8; k0 = (_u & 3) * 512 + ((j) & 7) * 64; } \
                                        else { const int _t = bid + (j) * G; valid = _t < nt_all; k0 = (_t % ntk) << 6; n0 = (_t / ntk) << 8; } } while (0)
#define CW_LOAD(v, j) do { bool _ok; int _k0, _n0; CW_COORD(j, _ok, _k0, _n0); if (_ok) { _Pragma("unroll") for (int i = 0; i < 8; ++i) v[i] = __builtin_nontemporal_load((const f32x4*)(W + (size_t)(_k0 + lk + 8 * i) * N + _n0 + ln4)); } } while (0)
#define CW_PROC(v, j, buf) do { bool _ok; int k0, n0; CW_COORD(j, _ok, k0, n0); if (!_ok) break; \
        LAS float* tile = lds_f + (buf) * TILE_F; \
        _Pragma("unroll") for (int i = 0; i < 8; ++i) { LAS float* tp = tile + (lk + 8 * i) * TP + ln4; tp[0] = v[i][0]; tp[1] = v[i][1]; tp[2] = v[i][2]; tp[3] = v[i][3]; } \
        __syncthreads(); \
        CW_LOAD(v, (j) + 2); \
        int nd = n0 + n; \
        if (ropeperm && nd >= 2048 && nd < 3328) { const int d = nd & 63; nd = nd - d + (d < 32 ? 2 * d : 2 * (d - 32) + 1); } \
        _Pragma("unroll") for (int jj = 0; jj < 4; ++jj) { \
            const int c = par + 2 * jj; const LAS float* tp = tile + (8 * c) * TP + n; \
            float w0 = tp[0 * TP], w1 = tp[1 * TP], w2 = tp[2 * TP], w3 = tp[3 * TP], w4 = tp[4 * TP], w5 = tp[5 * TP], w6 = tp[6 * TP], w7 = tp[7 * TP]; \
            if (FOLD) { \
                const f32x4 g0 = *(const f32x4*)(gvec + k0 + 8 * c), g1 = *(const f32x4*)(gvec + k0 + 8 * c + 4), b0 = *(const f32x4*)(bvec + k0 + 8 * c), b1 = *(const f32x4*)(bvec + k0 + 8 * c + 4); \
                bsum += ((w0 * b0[0] + w1 * b0[1]) + (w2 * b0[2] + w3 * b0[3])) + ((w4 * b1[0] + w5 * b1[1]) + (w6 * b1[2] + w7 * b1[3])); \
                w0 *= g0[0]; w1 *= g0[1]; w2 *= g0[2]; w3 *= g0[3]; w4 *= g1[0]; w5 *= g1[1]; w6 *= g1[2]; w7 *= g1[3]; } \
            u32x4 w; w.x = cvt_pk_bf16(w0, w1); w.y = cvt_pk_bf16(w2, w3); w.z = cvt_pk_bf16(w4, w5); w.w = cvt_pk_bf16(w6, w7); \
            *(u32x4*)(Wt + (size_t)nd * K + k0 + 8 * c) = w; \
            if (FOLD) csum += ((bf_lo(w.x) + bf_hi(w.x)) + (bf_lo(w.y) + bf_hi(w.y))) + ((bf_lo(w.z) + bf_hi(w.z)) + (bf_lo(w.w) + bf_hi(w.w))); } \
        if (FOLD && ((j) & 7) == 7) { \
            csum += shflx(csum, 1, tid & 63); bsum += shflx(bsum, 1, tid & 63); \
            if (par == 0) { const int q = (k0 >> 9); csP[(size_t)q * N + nd] = csum; csP[(size_t)(4 + q) * N + nd] = bsum; } \
            csum = 0.f; bsum = 0.f; } \
    } while (0)
    f32x4 va[8], vb[8];
    CW_LOAD(va, 0); CW_LOAD(vb, 1);
    for (int j = 0;; j += 2) {
        bool ok; int kk, nn; CW_COORD(j, ok, kk, nn); if (!ok) break;
        CW_PROC(va, j, 0);
        CW_PROC(vb, j + 1, 1);
    }
    __syncthreads();
#undef CW_COORD
#undef CW_LOAD
#undef CW_PROC
}
__device__ __forceinline__ void conv_wt(const float* __restrict__ W, bf16_t* __restrict__ Wt, int K, int N, bool ropeperm, LAS float* tile, const int tid, const int vbid, const int vG) {
    conv_wt_t<false>(W, Wt, K, N, ropeperm, nullptr, nullptr, nullptr, tile, tid, vbid, vG);
}
__device__ __forceinline__ void conv_wt_fold(const float* __restrict__ W, bf16_t* __restrict__ Wt, int N, bool ropeperm, const float* __restrict__ gvec, const float* __restrict__ bvec,
                                             float* __restrict__ csP, LAS float* tile, const int tid, const int vbid, const int vG) {
    conv_wt_t<true>(W, Wt, D, N, ropeperm, gvec, bvec, csP, tile, tid, vbid, vG);
}
__device__ __forceinline__ void cvt_bf16(const float* __restrict__ src, bf16_t* __restrict__ dst, size_t n, const int tid, const int bid) {
    for (size_t i = ((size_t)bid * 512 + tid) * 8; i < n; i += (size_t)gridDim.x * 512 * 8) {
        const f32x4 a = *(const f32x4*)(src + i), b = *(const f32x4*)(src + i + 4);
        *(u32x4*)(dst + i) = pack8(a, b);
    }
}
__device__ __forceinline__ void rope_table(float* tab, const int tid, const int bid) {
    for (int idx = bid * 512 + tid; idx < SEQ * 32; idx += gridDim.x * 512) {
        const int pos = idx >> 5, i = idx & 31;
        double invd = 1.0; for (int k = 0; k < i; ++k) invd *= 0.7498942093324558;
        const float ang = (float)pos * (float)invd;
        const double a = (double)ang, kq = __builtin_rint(a * 0.6366197723675814);
        const double r = (a - kq * 1.5707963267948966) - kq * 6.123233995736766e-17, r2 = r * r;
        const double sn = r * (1.0 + r2 * (-1.0 / 6 + r2 * (1.0 / 120 + r2 * (-1.0 / 5040 + r2 * (1.0 / 362880 + r2 * (-1.0 / 39916800 + r2 * (1.0 / 6227020800.0)))))));
        const double cs = 1.0 + r2 * (-0.5 + r2 * (1.0 / 24 + r2 * (-1.0 / 720 + r2 * (1.0 / 40320 + r2 * (-1.0 / 3628800 + r2 * (1.0 / 479001600 + r2 * (-1.0 / 87178291200.0)))))));
        const int qd = ((int)kq) & 3;
        const double s_ = (qd == 0) ? sn : (qd == 1) ? cs : (qd == 2) ? -sn : -cs;
        const double c_ = (qd == 0) ? cs : (qd == 1) ? -sn : (qd == 2) ? -cs : sn;
        tab[idx * 2] = (float)c_; tab[idx * 2 + 1] = (float)s_;
    }
}
__device__ __forceinline__ void ln_final(const bf16_t* tb, float* out, const float* __restrict__ g, const float* __restrict__ b, const int tid, const int bid) {
    const int wid = tid >> 6, lane = tid & 63;
    u32x4 wn[4];
    int row = bid * 8 + wid;
    if (row < M) {
#pragma unroll
        for (int i = 0; i < 4; ++i) wn[i] = *(const u32x4*)(tb + (size_t)row * D + i * 512 + lane * 8);
    }
    for (; row < M; row += gridDim.x * 8) {
        f32x4 v[8]; float s = 0.f;
#pragma unroll
        for (int i = 0; i < 4; ++i) {
            v[2 * i] = (f32x4){bf_lo(wn[i].x), bf_hi(wn[i].x), bf_lo(wn[i].y), bf_hi(wn[i].y)}; v[2 * i + 1] = (f32x4){bf_lo(wn[i].z), bf_hi(wn[i].z), bf_lo(wn[i].w), bf_hi(wn[i].w)};
            s += ((v[2 * i][0] + v[2 * i][1]) + (v[2 * i][2] + v[2 * i][3])) + ((v[2 * i + 1][0] + v[2 * i + 1][1]) + (v[2 * i + 1][2] + v[2 * i + 1][3]));
        }
        const int rn = row + gridDim.x * 8;
        if (rn < M) {
#pragma unroll
            for (int i = 0; i < 4; ++i) wn[i] = *(const u32x4*)(tb + (size_t)rn * D + i * 512 + lane * 8);
        }
        const float mean = wave_sum(s, lane) * (1.f / D); float q = 0.f;
#pragma unroll
        for (int i = 0; i < 8; ++i) { const f32x4 d = v[i] - mean; q += (d[0] * d[0] + d[1] * d[1]) + (d[2] * d[2] + d[3] * d[3]); }
        const float rstd = __builtin_amdgcn_rsqf(wave_sum(q, lane) * (1.f / D) + LN_EPS);
#pragma unroll
        for (int i = 0; i < 8; ++i) {
            const int c = (i >> 1) * 512 + lane * 8 + (i & 1) * 4;
            const f32x4 gg = *(const f32x4*)(g + c), bb = *(const f32x4*)(b + c);
            *(f32x4*)(out + (size_t)row * D + c) = (v[i] - mean) * rstd * gg + bb;
        }
    }
}
__device__ __forceinline__ bf16x8 as_bf16x8(u32x4 w) { union { u32x4 u; bf16x8 b; } x; x.u = w; return x.b; }
#define MFMA16(a, b, c) __builtin_amdgcn_mfma_f32_16x16x32_bf16((a), (b), (c), 0, 0, 0)

__device__ __forceinline__ void sgu_phase(const bf16_t* gu, const bf16_t* gv, const float* __restrict__ statsv, const float* __restrict__ lng, const float* __restrict__ lnb, const float* __restrict__ wsp, const float* __restrict__ bs,
                                          bf16_t* out, LAS unsigned char* lds, const int tid, const int bid) {
    constexpr int P = 272;
    const int wid = __builtin_amdgcn_readfirstlane(tid >> 6), lane = tid & 63, fr = lane & 15, fq = lane >> 4;
    LAS float* st = (LAS float*)lds; LAS unsigned char* vT = lds + 1024; LAS unsigned char* Wl = vT + 128 * P;
    f32x4 sv0, sv1, wv[8]; u32x4 gvw[4];
#define SGU_LOAD(u) do { const int _g = (u) & 7, _row0 = ((u) >> 8) * SEQ + (((u) >> 3) & 31) * 128; \
        const float* _sp = statsv + ((size_t)(_row0 + (tid >> 2)) * 16 + (tid & 3) * 4) * 2; sv0 = *(const f32x4*)_sp; sv1 = *(const f32x4*)(_sp + 4); \
        _Pragma("unroll") for (int i = 0; i < 4; ++i) gvw[i] = *(const u32x4*)(gv + (size_t)(_row0 + (tid & 127)) * GW + _g * 128 + ((tid >> 7) + 4 * i) * 8); \
        _Pragma("unroll") for (int i = 0; i < 8; ++i) wv[i] = *(const f32x4*)(wsp + ((size_t)_g * 128 + (tid >> 5) + 16 * i) * 128 + (tid & 31) * 4); } while (0)
    if (bid < 1024) SGU_LOAD(bid);
    for (int u = bid; u < 1024; u += gridDim.x) {
        const int g = u & 7, chunk = (u >> 3) & 31, b = u >> 8, row0 = b * SEQ + chunk * 128;
        {
            const int r = tid >> 2, part = tid & 3;
            float s1 = (sv0[0] + sv0[2]) + (sv1[0] + sv1[2]), s2 = (sv0[1] + sv0[3]) + (sv1[1] + sv1[3]);
            s1 += shflx(s1, 1, lane); s1 += shflx(s1, 2, lane); s2 += shflx(s2, 1, lane); s2 += shflx(s2, 2, lane);
            const float mean = s1 * (1.f / GW), var = s2 * (1.f / GW) - mean * mean;
            if (part == 0) { st[2 * r] = mean; st[2 * r + 1] = __builtin_amdgcn_rsqf(var + LN_EPS); }
        }
        __syncthreads();
        {
            const int s = tid & 127; const float mean = st[2 * s], rstd = st[2 * s + 1];
#pragma unroll
            for (int i = 0; i < 4; ++i) {
                const int c8 = (tid >> 7) + 4 * i, col = g * 128 + c8 * 8;
                const u32x4 w = gvw[i];
                const f32x4 g0 = *(const f32x4*)(lng + col), g1 = *(const f32x4*)(lng + col + 4), b0 = *(const f32x4*)(lnb + col), b1 = *(const f32x4*)(lnb + col + 4);
                LAS bf16_t* vp = (LAS bf16_t*)(vT + (c8 * 8) * P) + s;
                vp[0 * (P / 2)] = f2bf((bf_lo(w.x) - mean) * rstd * g0[0] + b0[0]); vp[1 * (P / 2)] = f2bf((bf_hi(w.x) - mean) * rstd * g0[1] + b0[1]);
                vp[2 * (P / 2)] = f2bf((bf_lo(w.y) - mean) * rstd * g0[2] + b0[2]); vp[3 * (P / 2)] = f2bf((bf_hi(w.y) - mean) * rstd * g0[3] + b0[3]);
                vp[4 * (P / 2)] = f2bf((bf_lo(w.z) - mean) * rstd * g1[0] + b1[0]); vp[5 * (P / 2)] = f2bf((bf_hi(w.z) - mean) * rstd * g1[1] + b1[1]);
                vp[6 * (P / 2)] = f2bf((bf_lo(w.w) - mean) * rstd * g1[2] + b1[2]); vp[7 * (P / 2)] = f2bf((bf_hi(w.w) - mean) * rstd * g1[3] + b1[3]);
            }
#pragma unroll
            for (int i = 0; i < 8; ++i) {
                const int t = (tid >> 5) + 16 * i, s4 = (tid & 31) * 4;
                u32x2 pk; pk.x = cvt_pk_bf16(s4 + 0 <= t ? wv[i][0] : 0.f, s4 + 1 <= t ? wv[i][1] : 0.f); pk.y = cvt_pk_bf16(s4 + 2 <= t ? wv[i][2] : 0.f, s4 + 3 <= t ? wv[i][3] : 0.f);
                *(LAS u32x2*)(Wl + t * P + s4 * 2) = pk;
            }
        }
        __syncthreads();
        if (u + (int)gridDim.x < 1024) SGU_LOAD(u + gridDim.x);
        {
            const int tf = wid, nks = (16 * tf + 15) / 32 + 1;
            const int t = 16 * tf + fr; const size_t ro = (size_t)(row0 + t) * GW + g * 128 + 4 * fq; const float bias = bs[g * 128 + t];
            u32x2 guw[8];
#pragma unroll
            for (int cf = 0; cf < 8; ++cf) guw[cf] = *(const u32x2*)(gu + ro + 16 * cf);
            f32x4 acc[8];
#pragma unroll
            for (int cf = 0; cf < 8; ++cf) acc[cf] = (f32x4){0.f, 0.f, 0.f, 0.f};
#pragma unroll
            for (int ks = 0; ks < 4; ++ks)
                if (ks < nks) {
                    const bf16x8 Bf = *(const LAS bf16x8*)(Wl + (16 * tf + fr) * P + (32 * ks + 8 * fq) * 2);
#pragma unroll
                    for (int cf = 0; cf < 8; ++cf) { const bf16x8 Af = *(const LAS bf16x8*)(vT + (16 * cf + fr) * P + (32 * ks + 8 * fq) * 2); acc[cf] = MFMA16(Af, Bf, acc[cf]); }
                }
#pragma unroll
            for (int cf = 0; cf < 8; ++cf) {
                const u32x2 gw = guw[cf];
                u32x2 o; o.x = cvt_pk_bf16(bf_lo(gw.x) * (acc[cf][0] + bias), bf_hi(gw.x) * (acc[cf][1] + bias)); o.y = cvt_pk_bf16(bf_lo(gw.y) * (acc[cf][2] + bias), bf_hi(gw.y) * (acc[cf][3] + bias));
                *(u32x2*)(out + ro + 16 * cf) = o;
            }
        }
    }
    __syncthreads();
#undef SGU_LOAD
}

__device__ __forceinline__ void swa_phase(const bf16_t* q, const bf16_t* kb, const bf16_t* vb, const float* __restrict__ sinks, bf16_t* out, LAS unsigned char* lds, const int tid, const int bid) {
    constexpr int KP = 144, VP = 528;
    const int wid = __builtin_amdgcn_readfirstlane(tid >> 6), lane = tid & 63, fr = lane & 15, fq = lane >> 4;
    LAS unsigned char* Kl = lds; LAS unsigned char* Vt = lds + 256 * KP;
    u32x4 kreg[4], vreg[4];
#define SWA_LOAD(u) do { const int _uu = (gridDim.x == 256) ? ((u) & 7) * 64 + ((u) >> 8) * 32 + (((u) >> 3) & 31) : (u); const int _hkv = (_uu >> 5) & 3, _blk = _uu & 31, _rb = (_uu >> 7) * SEQ + _blk * 128; \
        _Pragma("unroll") for (int i = 0; i < 4; ++i) { const int key = (tid >> 3) + 64 * i; kreg[i] = (u32x4){0u, 0u, 0u, 0u}; \
            if (_blk > 0 || key >= 128) kreg[i] = *(const u32x4*)(kb + (size_t)(_rb - 128 + key) * KVW + _hkv * 64 + (tid & 7) * 8); } \
        _Pragma("unroll") for (int i = 0; i < 4; ++i) { const int key = lane + 64 * i; vreg[i] = (u32x4){0u, 0u, 0u, 0u}; \
            if (_blk > 0 || key >= 128) vreg[i] = *(const u32x4*)(vb + (size_t)(_rb - 128 + key) * KVW + _hkv * 64 + wid * 8); } } while (0)
    if (bid < 512) SWA_LOAD(bid);
    for (int u = bid; u < 512; u += gridDim.x) {
        const int uu = (gridDim.x == 256) ? (u & 7) * 64 + (u >> 8) * 32 + ((u >> 3) & 31) : u;
        const int hkv = (uu >> 5) & 3, blk = uu & 31, b = uu >> 7, rowbase = b * SEQ + blk * 128;
#pragma unroll
        for (int i = 0; i < 4; ++i) {
            const int key = (tid >> 3) + 64 * i, d8 = (tid & 7) * 8;
            *(LAS u32x4*)(Kl + key * KP + d8 * 2) = kreg[i];
        }
#pragma unroll
        for (int i = 0; i < 4; ++i) {
            const int key = lane + 64 * i;
            const u32x4 w = vreg[i];
            LAS bf16_t* vp = (LAS bf16_t*)(Vt + (wid * 8) * VP) + key;
            vp[0 * (VP / 2)] = (bf16_t)(w.x & 0xffffu); vp[1 * (VP / 2)] = (bf16_t)(w.x >> 16); vp[2 * (VP / 2)] = (bf16_t)(w.y & 0xffffu); vp[3 * (VP / 2)] = (bf16_t)(w.y >> 16);
            vp[4 * (VP / 2)] = (bf16_t)(w.z & 0xffffu); vp[5 * (VP / 2)] = (bf16_t)(w.z >> 16); vp[6 * (VP / 2)] = (bf16_t)(w.w & 0xffffu); vp[7 * (VP / 2)] = (bf16_t)(w.w >> 16);
        }
        __syncthreads();
        if (u + (int)gridDim.x < 512) SWA_LOAD(u + gridDim.x);
        const int g = wid >> 1, half = wid & 1, h = hkv * 4 + g;
        const float sink = sinks[h];
        bf16x8 Qa[4], Qb[4];
#pragma unroll
        for (int mf = 0; mf < 4; ++mf) { const bf16_t* qp = q + (size_t)(rowbase + 64 * half + 16 * mf + fr) * AW + h * 64 + fq * 8; Qa[mf] = *(const bf16x8*)qp; Qb[mf] = *(const bf16x8*)(qp + 32); }
#pragma unroll
        for (int mf = 0; mf < 4; ++mf) {
            const int qb = 64 * half + 16 * mf, nb = qb >> 4, ql = qb + fr;
            const bf16x8 Q0 = Qa[mf], Q1 = Qb[mf];
            f32x4 s[9];
#pragma unroll
            for (int n = 0; n < 9; ++n) {
                const LAS unsigned char* kr = Kl + (16 * (nb + n) + fr) * KP + fq * 16;
                const bf16x8 K0 = *(const LAS bf16x8*)kr, K1 = *(const LAS bf16x8*)(kr + 64);
                s[n] = MFMA16(K0, Q0, ((f32x4){0.f, 0.f, 0.f, 0.f})); s[n] = MFMA16(K1, Q1, s[n]);
            }
            float mx = -INFINITY;
#pragma unroll
            for (int n = 0; n < 9; ++n)
#pragma unroll
                for (int j = 0; j < 4; ++j) {
                    const int kl = 16 * (nb + n) + 4 * fq + j;
                    const bool valid = (kl > ql) && (kl <= ql + 128) && (blk > 0 || kl >= 128);
                    s[n][j] = valid ? s[n][j] : -INFINITY; mx = fmaxf(mx, s[n][j]);
                }
            mx = fmaxf(mx, shflx(mx, 16, lane)); mx = fmaxf(mx, shflx(mx, 32, lane)); mx = fmaxf(mx, sink);
            float sum = 0.f;
#pragma unroll
            for (int n = 0; n < 9; ++n)
#pragma unroll
                for (int j = 0; j < 4; ++j) { const float pj = __expf(s[n][j] - mx); s[n][j] = pj; sum += pj; }
            sum += shflx(sum, 16, lane); sum += shflx(sum, 32, lane); sum += __expf(sink - mx);
            f32x4 o[4];
#pragma unroll
            for (int dn = 0; dn < 4; ++dn) o[dn] = (f32x4){0.f, 0.f, 0.f, 0.f};
#pragma unroll
            for (int pr = 0; pr < 5; ++pr) {
                const int n0 = 2 * pr;
                const bf16x8 Pf = as_bf16x8(pack8(s[n0], (n0 + 1 < 9) ? s[n0 + 1 < 9 ? n0 + 1 : 8] : ((f32x4){0.f, 0.f, 0.f, 0.f})));
                const int k0 = 16 * (nb + n0) + 4 * fq, k1 = (n0 + 1 < 9) ? k0 + 16 : k0;
#pragma unroll
                for (int dn = 0; dn < 4; ++dn) {
                    const LAS unsigned char* vr = Vt + (16 * dn + fr) * VP;
                    const u32x2 lo = *(const LAS u32x2*)(vr + k0 * 2), hi = *(const LAS u32x2*)(vr + k1 * 2);
                    o[dn] = MFMA16(as_bf16x8((u32x4){lo.x, lo.y, hi.x, hi.y}), Pf, o[dn]);
                }
            }
            const float inv = 1.f / sum;
            bf16_t* op = out + (size_t)(rowbase + ql) * AW + h * 64 + 4 * fq;
#pragma unroll
            for (int dn = 0; dn < 4; ++dn) { u32x2 w; w.x = cvt_pk_bf16(o[dn][0] * inv, o[dn][1] * inv); w.y = cvt_pk_bf16(o[dn][2] * inv, o[dn][3] * inv); *(u32x2*)(op + 16 * dn) = w; }
        }
        __syncthreads();
    }
}

__device__ __forceinline__ void xatt_phase(const bf16_t* xq, const bf16_t* xk, const bf16_t* xvt, bf16_t* xo, LAS unsigned char* lds, const int tid, const int bid) {
    constexpr int KP = 272, VP = 528;
    const int wid = __builtin_amdgcn_readfirstlane(tid >> 6), lane = tid & 63, fr = lane & 15, fq = lane >> 4;
    LAS unsigned char* Kl = lds; LAS unsigned char* Vt = lds + 256 * KP;
    for (int u0 = bid; u0 < 256; u0 += gridDim.x) {
        const int u = (gridDim.x == 256) ? (u0 & 7) * 32 + (u0 >> 3) : u0;
        const int qt = u & 15, xh = (u >> 4) & 3, b = u >> 6;
        const bf16_t* kbase = xk + (size_t)(b * 256) * XW + xh * 128; const bf16_t* vtbase = xvt + (size_t)(xh * 128) * MROWS + b * 256;
#pragma unroll
        for (int i = 0; i < 8; ++i) {
            const int key = (tid >> 4) + 32 * i, d8 = (tid & 15) * 8;
            *(LAS u32x4*)(Kl + key * KP + d8 * 2) = *(const u32x4*)(kbase + (size_t)key * XW + d8);
        }
#pragma unroll
        for (int i = 0; i < 8; ++i) {
            const int d = tid >> 2, c = 4 * i + (tid & 3);
            *(LAS u32x4*)(Vt + d * VP + c * 16) = *(const u32x4*)(vtbase + (size_t)d * MROWS + c * 8);
        }
        __syncthreads();
        for (int mf = 0; mf < 2; ++mf) {
            const size_t qrow = (size_t)b * SEQ + qt * 256 + wid * 32 + mf * 16 + fr;
            const bf16_t* qp = xq + qrow * XW + xh * 128 + fq * 8;
            bf16x8 Q[4];
#pragma unroll
            for (int ks = 0; ks < 4; ++ks) Q[ks] = *(const bf16x8*)(qp + 32 * ks);
            f32x4 s[16];
#pragma unroll
            for (int n = 0; n < 16; ++n) {
                const LAS unsigned char* kr = Kl + (16 * n + fr) * KP + fq * 16;
                s[n] = (f32x4){0.f, 0.f, 0.f, 0.f};
#pragma unroll
                for (int ks = 0; ks < 4; ++ks) s[n] = MFMA16(*(const LAS bf16x8*)(kr + 64 * ks), Q[ks], s[n]);
            }
            float mx = -INFINITY;
#pragma unroll
            for (int n = 0; n < 16; ++n) mx = fmaxf(mx, fmaxf(fmaxf(s[n][0], s[n][1]), fmaxf(s[n][2], s[n][3])));
            mx = fmaxf(mx, shflx(mx, 16, lane)); mx = fmaxf(mx, shflx(mx, 32, lane));
            float sum = 0.f;
#pragma unroll
            for (int n = 0; n < 16; ++n)
#pragma unroll
                for (int j = 0; j < 4; ++j) { const float pj = __expf(s[n][j] - mx); s[n][j] = pj; sum += pj; }
            sum += shflx(sum, 16, lane); sum += shflx(sum, 32, lane);
            f32x4 o[8];
#pragma unroll
            for (int dn = 0; dn < 8; ++dn) o[dn] = (f32x4){0.f, 0.f, 0.f, 0.f};
#pragma unroll
            for (int pr = 0; pr < 8; ++pr) {
                const bf16x8 Pf = as_bf16x8(pack8(s[2 * pr], s[2 * pr + 1]));
                const int k0 = 32 * pr + 4 * fq;
#pragma unroll
                for (int dn = 0; dn < 8; ++dn) {
                    const LAS unsigned char* vr = Vt + (16 * dn + fr) * VP + k0 * 2;
                    const u32x2 lo = *(const LAS u32x2*)vr, hi = *(const LAS u32x2*)(vr + 32);
                    o[dn] = MFMA16(as_bf16x8((u32x4){lo.x, lo.y, hi.x, hi.y}), Pf, o[dn]);
                }
            }
            const float inv = 1.f / sum;
            bf16_t* op = xo + qrow * XW + xh * 128 + 4 * fq;
#pragma unroll
            for (int dn = 0; dn < 8; ++dn) { u32x2 w; w.x = cvt_pk_bf16(o[dn][0] * inv, o[dn][1] * inv); w.y = cvt_pk_bf16(o[dn][2] * inv, o[dn][3] * inv); *(u32x2*)(op + 16 * dn) = w; }
        }
        __syncthreads();
    }
}


#define XB_TMO      128
#define XB_XCNT(j)  (256  + 64 * (j))
#define XB_XSUB(j)  (1280 + 64 * (j))
#define XB_XGEN(j)  (2304 + 64 * (j))
#define XB_TOP      3328
#define XB_TOPGEN   3392
#define XCD_BAR_WORDS 3456
#define XB_SPIN_CAP (1u << 18)
__device__ __forceinline__ unsigned xb_ld(unsigned* p)              { return __hip_atomic_load(p, __ATOMIC_RELAXED, __HIP_MEMORY_SCOPE_AGENT); }
__device__ __forceinline__ unsigned xb_add(unsigned* p, unsigned v) { return __hip_atomic_fetch_add(p, v, __ATOMIC_RELAXED, __HIP_MEMORY_SCOPE_AGENT); }
__device__ __forceinline__ unsigned xb_xcc_id() { return (unsigned)__builtin_amdgcn_s_getreg((3 << 11) | 20) & 0xFu; }
#define XB_SPIN(cond, bar) do { unsigned _sp = 0; while (cond) { __builtin_amdgcn_s_sleep(1); \
    if ((++_sp & 255u) == 0u) { if (xb_ld(&(bar)[XB_TMO])) break; if (_sp > XB_SPIN_CAP) { atomicAdd(&(bar)[XB_TMO], 1u); break; } } } } while (0)
struct XcdBarrier { unsigned* bar; unsigned x; volatile LAS unsigned* st; };
__device__ __forceinline__ XcdBarrier xcd_barrier_post(unsigned* bar, volatile LAS unsigned* st) {
    XcdBarrier b; b.bar = bar; b.x = xb_xcc_id(); b.st = st;
    if (threadIdx.x == 0) (void)xb_add(&bar[XB_XCNT(b.x)], 1u);
    return b;
}
__device__ __forceinline__ void xcd_barrier_complete(unsigned* bar, unsigned x, unsigned& nloc, unsigned& nx) {
    const unsigned G = gridDim.x * gridDim.y * gridDim.z;
    unsigned sum, cnt, mine, sp = 0u;
    for (;;) {
        sum = 0u; cnt = 0u; mine = 0u;
#pragma unroll
        for (unsigned j = 0; j < 16; ++j) { const unsigned c = xb_ld(&bar[XB_XCNT(j)]); sum += c; cnt += (c > 0u) ? 1u : 0u; mine = (j == x) ? c : mine; }
        if (sum == G) break;
        __builtin_amdgcn_s_sleep(1);
        if ((++sp & 255u) == 0u) { if (xb_ld(&bar[XB_TMO])) break; if (sp > XB_SPIN_CAP) { atomicAdd(&bar[XB_TMO], 1u); break; } }
    }
    nloc = mine > 0u ? mine : 1u; nx = cnt > 0u ? cnt : 1u;
}
__device__ __forceinline__ void xcd_barrier(const XcdBarrier& b) {
    asm volatile("s_waitcnt vmcnt(0)" ::: "memory");
    __syncthreads();
    if (threadIdx.x == 0) {
        unsigned* bar = b.bar; asm volatile("" : "+s"(bar));
        __builtin_amdgcn_s_waitcnt(0);
        unsigned nloc = b.st[0], nx = b.st[1];
        if (nloc == 0u) { xcd_barrier_complete(bar, b.x, nloc, nx); b.st[0] = nloc; b.st[1] = nx; }
        const unsigned old = xb_add(&bar[XB_XSUB(b.x)], 1u);
        const unsigned gen = old / nloc;
        if (old + 1u == (gen + 1u) * nloc) {
            __builtin_amdgcn_fence(__ATOMIC_RELEASE, "agent");
            asm volatile("s_waitcnt vmcnt(0)" ::: "memory");
            const unsigned og = xb_add(&bar[XB_TOP], 1u);
            const unsigned tg = og / nx;
            if (og + 1u == (tg + 1u) * nx) xb_add(&bar[XB_TOPGEN], 1u);
            else XB_SPIN(xb_ld(&bar[XB_TOPGEN]) == tg, bar);
            __builtin_amdgcn_fence(__ATOMIC_ACQUIRE, "agent");
            xb_add(&bar[XB_XGEN(b.x)], 1u);
            asm volatile("s_waitcnt vmcnt(0)" ::: "memory");
        } else {
            XB_SPIN(xb_ld(&bar[XB_XGEN(b.x)]) == gen, bar);
            __builtin_amdgcn_fence(__ATOMIC_ACQUIRE, "agent");
            asm volatile("s_waitcnt vmcnt(0)" ::: "memory");
        }
    }
    __syncthreads();
}

__global__ void __launch_bounds__(512, 2) fwd_kernel(Params p) {
    extern __shared__ __attribute__((aligned(16))) unsigned char lds_raw[];
    LAS unsigned char* lds = (LAS unsigned char*)lds_raw;
    cg::grid_group grid = cg::this_grid();
    volatile LAS unsigned* xb_st = (volatile LAS unsigned*)(lds + LDS_BYTES - 16);
    if (threadIdx.x == 0) { xb_st[0] = 0u; xb_st[1] = 0u; }
    __syncthreads();
    const XcdBarrier xbar = xcd_barrier_post((unsigned*)(p.ws + WS_BAR), xb_st);
    if (p.ph_lo == 0) {
        unsigned char* ws = p.ws; asm volatile("" : "+s"(ws));
        int tid = threadIdx.x; asm volatile("" : "+v"(tid));
        int bid = blockIdx.x; asm volatile("" : "+s"(bid));
        cvt_bf16(p.in[0], (bf16_t*)(ws + WS_XB), (size_t)M * D, tid, bid); cvt_bf16(p.in[1], (bf16_t*)(ws + WS_MEMB), (size_t)MROWS * D, tid, bid); rope_table((float*)(ws + WS_ROPE), tid, bid);
    }
    for (int ph = p.ph_lo; ph < p.ph_hi; ++ph) {
        if (ph > p.ph_lo) { if (p.ph_hi < 0) grid.sync(); else xcd_barrier(xbar); }
        unsigned char* ws = p.ws; asm volatile("" : "+s"(ws));
        int tid = threadIdx.x; asm volatile("" : "+v"(tid));
        int bid = blockIdx.x; asm volatile("" : "+s"(bid));
        int z0 = 0; asm volatile("" : "+s"(z0));
        bf16_t* Wt_in = (bf16_t*)(ws + WS_WIN); bf16_t* Wt_bra = (bf16_t*)(ws + WS_WBRA); bf16_t* Wt_brb = (bf16_t*)(ws + WS_WBRB); bf16_t* Wt_o = (bf16_t*)(ws + WS_WO);
        bf16_t* Wt_xq = (bf16_t*)(ws + WS_WXQ); bf16_t* Wt_xkv = (bf16_t*)(ws + WS_WXKV); bf16_t* Wt_xo = (bf16_t*)(ws + WS_WXO); bf16_t* Wt_up = (bf16_t*)(ws + WS_WUP); bf16_t* Wt_dn = (bf16_t*)(ws + WS_WDN);
        bf16_t* TB = (bf16_t*)(ws + WS_XB);
        bf16_t* GU = (bf16_t*)(ws + WS_R1 + R1_GU); bf16_t* GV = (bf16_t*)(ws + WS_R1 + R1_GV); bf16_t* QB = (bf16_t*)(ws + WS_R1 + R1_Q); bf16_t* KB = (bf16_t*)(ws + WS_R1 + R1_K);
        bf16_t* VB = (bf16_t*)(ws + WS_R1 + R1_V); bf16_t* SA = (bf16_t*)(ws + WS_R1 + R1_SA); bf16_t* SB = (bf16_t*)(ws + WS_R1 + R1_SB); bf16_t* HB = (bf16_t*)(ws + WS_R1);
        bf16_t* MERGED = GU;
        bf16_t* SGUO = (bf16_t*)(ws + WS_R2); bf16_t* ATTO = (bf16_t*)(ws + WS_R2 + (size_t)M * GW * 2); bf16_t* XQ = SGUO; bf16_t* XO = ATTO;
        bf16_t* MEMB = (bf16_t*)(ws + WS_MEMB); bf16_t* XKV = (bf16_t*)(ws + WS_XKV); float* ROPE = (float*)(ws + WS_ROPE);
        float* STATSV = (float*)(ws + WS_STATSV); float* CSB = (float*)(ws + WS_CS);
        float* X = p.out;
        const int G = gridDim.x;
        if (ph == DEPTH * NPH) { ln_final(TB, X, p.in[z0 + 21] + (size_t)(DEPTH - 1) * D, p.in[z0 + 22] + (size_t)(DEPTH - 1) * D, tid, bid); break; }
        const int l = ph / NPH, k = ph % NPH;
        float* ST0 = (float*)(ws + WS_STATS) + (size_t)((3 * l + 0) & 1) * M * 64; float* ST1 = (float*)(ws + WS_STATS) + (size_t)((3 * l + 1) & 1) * M * 64;
        float* ST2 = (float*)(ws + WS_STATS) + (size_t)((3 * l + 2) & 1) * M * 64;
        const float* STP = ST1;
        switch (k) {
        case 0: {
#define VB(start, lo, n) ((bid >= (lo) && bid < (lo) + (n)) ? (bid - (lo) - (start) + 2 * (n)) % (n) : -1)
            conv_wt_fold(p.in[z0 + 14] + (size_t)l * D * XW, Wt_xq, XW, false, p.in[z0 + 12] + (size_t)l * D, p.in[z0 + 13] + (size_t)l * D, CSB + CS_XQ, (LAS float*)lds, tid, VB(0, G - 8, 8), 8);
            if (l == 0) {
                conv_wt(p.in[z0 + 2], Wt_in, D, NIN, true, (LAS float*)lds, tid, VB(0, 0, 248), 248);
                conv_wt(p.in[z0 + 9], Wt_bra, GW, D, false, (LAS float*)lds, tid, VB(216, 0, 248), 248);
                conv_wt(p.in[z0 + 10], Wt_brb, AW, D, false, (LAS float*)lds, tid, VB(96, 0, 248), 248);
                conv_wt(p.in[z0 + 11], Wt_o, D, D, false, (LAS float*)lds, tid, VB(224, 0, 248), 248);
                conv_wt(p.in[z0 + 15], Wt_xkv, D, 2 * XW, false, (LAS float*)lds, tid, VB(232, 0, 248), 248);
                conv_wt(p.in[z0 + 16], Wt_xo, XW, D, false, (LAS float*)lds, tid, VB(112, 0, 248), 248);
            } else {
                conv_wt_fold(p.in[z0 + 2] + (size_t)l * D * NIN, Wt_in, NIN, true, p.in[z0 + 21] + (size_t)(l - 1) * D, p.in[z0 + 22] + (size_t)(l - 1) * D, CSB + CS_IN, (LAS float*)lds, tid, VB(0, 0, 120), 120);
                conv_wt(p.in[z0 + 9] + (size_t)l * GW * D, Wt_bra, GW, D, false, (LAS float*)lds, tid, VB(0, 120, 128), 128);
                conv_wt(p.in[z0 + 10] + (size_t)l * AW * D, Wt_brb, AW, D, false, (LAS float*)lds, tid, VB(0, 120, 128), 128);
                conv_wt(p.in[z0 + 11] + (size_t)l * D * D, Wt_o, D, D, false, (LAS float*)lds, tid, VB(0, 120, 128), 128);
                conv_wt(p.in[z0 + 15] + (size_t)l * D * 2 * XW, Wt_xkv, D, 2 * XW, false, (LAS float*)lds, tid, VB(0, 120, 128), 128);
                conv_wt(p.in[z0 + 16] + (size_t)l * XW * D, Wt_xo, XW, D, false, (LAS float*)lds, tid, VB(64, 120, 128), 128);
            }
#undef VB
        } break;
        case 1: {
            { pg8::Gemm g{TB, Wt_in, M, NIN, D, nullptr, nullptr}; pg8::StaticOrder S; S.init(M, NIN, G, bid);
              EpiIn E{GU, GV, QB, KB, VB, SA, SB, p.in[z0 + 3] + (size_t)l * 2 * D, ROPE, STATSV, Fold{l == 0 ? (const float*)nullptr : STP, CSB + CS_IN, NIN}};
              pg8::gemm_phase<EpiIn>(lds, g, S, E, tid); }
            asm volatile("" : "+v"(tid));
            { pg8::Gemm g{MEMB, Wt_xkv, MROWS, XW, D, nullptr, nullptr}; pg8::StaticOrder S; S.init(MROWS, XW, G, (bid + G / 2) % G);
              EpiB<0> E{XKV, XW, 1.0f, nullptr, Fold{nullptr, nullptr, 0}};
              pg8::gemm_phase<EpiB<0>>(lds, g, S, E, tid); }
            asm volatile("" : "+v"(tid));
            { pg8::Gemm g{Wt_xkv + (size_t)XW * D, MEMB, XW, MROWS, D, nullptr, nullptr}; pg8::StaticOrder S; S.init(XW, MROWS, G, (bid + G / 2 - 8) % G);
              EpiB<0> E{XKV + (size_t)MROWS * XW, MROWS, 1.0f, nullptr, Fold{nullptr, nullptr, 0}};
              pg8::gemm_phase<EpiB<0>>(lds, g, S, E, tid); }
            asm volatile("" : "+v"(tid));
            conv_wt(p.in[z0 + 20] + (size_t)l * FF * D, Wt_dn, FF, D, false, (LAS float*)lds, tid, bid >= 144 ? bid - 144 : -1, G - 144);
        } break;
        case 2: {
            sgu_phase(GU, GV, STATSV, p.in[z0 + 4] + (size_t)l * GW, p.in[z0 + 5] + (size_t)l * GW, p.in[z0 + 6] + (size_t)l * 8 * 128 * 128, p.in[z0 + 7] + (size_t)l * 8 * 128, SGUO, lds, tid, bid);
            asm volatile("" : "+v"(tid));
            swa_phase(QB, KB, VB, p.in[z0 + 8] + (size_t)l * 16, ATTO, lds, tid, bid);
        } break;
        case 3: {
            pg8::Gemm g{SGUO, Wt_bra, M, D, GW, ATTO, Wt_brb}; pg8::StaticOrder S; S.init(M, D, G, bid, 1); EpiBR E{MERGED, SA, SB}; pg8::gemm_phase<EpiBR>(lds, g, S, E, tid); } break;
        case 4: {
            pg8::Gemm g{MERGED, Wt_o, M, D, D, nullptr, nullptr}; pg8::StaticOrder S; S.init(M, D, G, bid, 1);
            EpiRes E{p.in[z0 + 0], nullptr, TB, p.in[z0 + 21] + (size_t)(l > 0 ? l - 1 : 0) * D, p.in[z0 + 22] + (size_t)(l > 0 ? l - 1 : 0) * D, ST0, Fold{l == 0 ? (const float*)nullptr : STP, nullptr, 0}};
            pg8::gemm_phase<EpiRes>(lds, g, S, E, tid); } break;
        case 5: { pg8::Gemm g{TB, Wt_xq, M, XW, D, nullptr, nullptr}; pg8::StaticOrder S; S.init(M, XW, G, bid); EpiB<0> E{XQ, XW, 0.08838834764831845f, nullptr, Fold{ST0, CSB + CS_XQ, XW}}; pg8::gemm_phase<EpiB<0>>(lds, g, S, E, tid);
            asm volatile("" : "+v"(tid));
            conv_wt_fold(p.in[z0 + 19] + (size_t)l * D * FF, Wt_up, FF, false, p.in[z0 + 17] + (size_t)l * D, p.in[z0 + 18] + (size_t)l * D, CSB + CS_UP, (LAS float*)lds, tid, bid >= 128 ? bid - 128 : -1, G - 128); } break;
        case 6: xatt_phase(XQ, XKV, XKV + (size_t)MROWS * XW, XO, lds, tid, bid); break;
        case 7: { pg8::Gemm g{XO, Wt_xo, M, D, XW, nullptr, nullptr}; pg8::StaticOrder S; S.init(M, D, G, bid);
            EpiRes E{nullptr, nullptr, TB, p.in[z0 + 12] + (size_t)l * D, p.in[z0 + 13] + (size_t)l * D, ST1, Fold{ST0, nullptr, 0}}; pg8::gemm_phase<EpiRes>(lds, g, S, E, tid); } break;
        case 8: { pg8::Gemm g{TB, Wt_up, M, FF, D, nullptr, nullptr}; pg8::StaticOrder S; S.init(M, FF, G, bid); EpiB<1> E{HB, FF, 1.f, nullptr, Fold{ST1, CSB + CS_UP, FF}}; pg8::gemm_phase<EpiB<1>>(lds, g, S, E, tid); } break;
        case 9: { pg8::Gemm g{HB, Wt_dn, M, D, FF, nullptr, nullptr}; pg8::StaticOrder S; S.init(M, D, G, bid, 1);
            EpiRes E{nullptr, nullptr, TB, p.in[z0 + 17] + (size_t)l * D, p.in[z0 + 18] + (size_t)l * D, ST2, Fold{ST1, nullptr, 0}}; pg8::gemm_phase<EpiRes>(lds, g, S, E, tid); } break;
        }
    }
}

extern "C" void kernel_launch(void* const* d_in, const int* in_sizes, int n_in, void* d_out, int out_size, void* d_ws, size_t ws_size, hipStream_t stream) {
    static int grid = 0;
    if (grid == 0) {
        if (n_in != 23 || out_size != M * D || ws_size < WS_END) { fprintf(stderr, "kernel_launch: unexpected shapes (n_in %d out %d ws %zu need %zu)\n", n_in, out_size, ws_size, (size_t)WS_END); grid = -1; return; }
        int dev = 0, cus = 0, per_cu = 0;
        hipGetDevice(&dev);
        hipDeviceGetAttribute(&cus, hipDeviceAttributeMultiprocessorCount, dev);
        if (hipFuncSetAttribute((const void*)fwd_kernel, hipFuncAttributeMaxDynamicSharedMemorySize, LDS_BYTES) != hipSuccess) { fprintf(stderr, "kernel_launch: hipFuncSetAttribute failed\n"); grid = -1; return; }
        if (hipOccupancyMaxActiveBlocksPerMultiprocessor(&per_cu, (const void*)fwd_kernel, 512, LDS_BYTES) != hipSuccess || per_cu < 1) { fprintf(stderr, "kernel_launch: occupancy query gave %d\n", per_cu); per_cu = 1; }
        (void)hipGetLastError();
        grid = cus;
    }
    if (grid < 0) return;
    Params p{};
    for (int i = 0; i < 23; ++i) p.in[i] = (const float*)d_in[i];
    p.out = (float*)d_out; p.ws = (unsigned char*)d_ws;
#if LAUNCH_PER_PHASE
    for (int ph = 0; ph < DEPTH * NPH + 1; ++ph) {
        p.ph_lo = ph; p.ph_hi = ph + 1;
        hipLaunchKernelGGL(fwd_kernel, dim3(grid), dim3(512), LDS_BYTES, stream, p);
    }
#else
    p.ph_lo = 0; p.ph_hi = DEPTH * NPH + 1;
    (void)hipMemsetAsync((unsigned char*)d_ws + WS_BAR, 0, (size_t)XCD_BAR_WORDS_C * 4, stream);
    void* args[] = {&p};
    hipError_t e = hipLaunchCooperativeKernel((const void*)fwd_kernel, dim3(grid), dim3(512), args, LDS_BYTES, stream);
    if (e != hipSuccess) fprintf(stderr, "cooperative launch failed: %s (grid %d)\n", hipGetErrorString(e), grid);
#endif
}
```

```cpp
#include <hip/hip_runtime.h>
#include <hip/hip_cooperative_groups.h>
#include <cstdio>
namespace cg = cooperative_groups;

#ifndef LAUNCH_PER_PHASE
#define LAUNCH_PER_PHASE 0
#endif

#define LAS __attribute__((address_space(3)))
typedef unsigned short bf16_t;
typedef short bf16x8 __attribute__((ext_vector_type(8)));
typedef float f32x4 __attribute__((ext_vector_type(4)));
typedef unsigned u32x4 __attribute__((ext_vector_type(4)));
typedef unsigned u32x2 __attribute__((ext_vector_type(2)));

constexpr int M = 16384, D = 2048, SEQ = 4096, NIN = 7680, GW = 1024, AW = 1024, KVW = 256, XW = 512, FF = 8192, MROWS = 1024, DEPTH = 2;
constexpr float ALPHA = 1.4142135623730951f, LN_EPS = 1e-5f;
constexpr int LDS_BYTES = 144384;
constexpr int RS_OFF = 131072, CV_OFF = 135168;
constexpr int NPH = 10;
constexpr int XCD_BAR_WORDS_C = 3456;

constexpr size_t WS_WIN = 0;
constexpr size_t WS_WBRA = WS_WIN + (size_t)NIN * D * 2;
constexpr size_t WS_WBRB = WS_WBRA + (size_t)D * GW * 2;
constexpr size_t WS_WO = WS_WBRB + (size_t)D * AW * 2;
constexpr size_t WS_WXQ = WS_WO + (size_t)D * D * 2;
constexpr size_t WS_WXKV = WS_WXQ + (size_t)XW * D * 2;
constexpr size_t WS_WXO = WS_WXKV + (size_t)2 * XW * D * 2;
constexpr size_t WS_WUP = WS_WXO + (size_t)D * XW * 2;
constexpr size_t WS_WDN = WS_WUP + (size_t)FF * D * 2;
constexpr size_t WS_XB = WS_WDN + (size_t)D * FF * 2;
constexpr size_t WS_R1 = WS_XB + (size_t)M * D * 2;
constexpr size_t R1_GU = 0, R1_GV = R1_GU + (size_t)M * GW * 2, R1_Q = R1_GV + (size_t)M * GW * 2, R1_K = R1_Q + (size_t)M * AW * 2,
                 R1_V = R1_K + (size_t)M * KVW * 2, R1_SA = R1_V + (size_t)M * KVW * 2, R1_SB = R1_SA + (size_t)M * D * 2;
constexpr size_t WS_R2 = WS_R1 + (size_t)M * FF * 2;
constexpr size_t WS_MEMB = WS_R2 + (size_t)M * D * 2;
constexpr size_t WS_XKV = WS_MEMB + (size_t)MROWS * D * 2;
constexpr size_t WS_ROPE = WS_XKV + (size_t)MROWS * 2 * XW * 2;
constexpr size_t WS_BAR = WS_ROPE + (size_t)SEQ * 32 * 2 * 4;
constexpr size_t WS_STATS = WS_BAR + (size_t)XCD_BAR_WORDS_C * 4;
constexpr size_t WS_STATSV = WS_STATS + (size_t)2 * M * 32 * 2 * 4;
constexpr size_t WS_CS = WS_STATSV + (size_t)M * 16 * 2 * 4;
constexpr size_t CS_IN = 0, CS_XQ = CS_IN + (size_t)8 * NIN, CS_UP = CS_XQ + (size_t)8 * XW, CS_END_F = CS_UP + (size_t)8 * FF;
constexpr size_t WS_WSB = WS_CS + CS_END_F * 4;
constexpr size_t WS_END = WS_WSB + (size_t)8 * 128 * 128 * 2;

struct Params {
    const float* in[23];
    float* out;
    unsigned char* ws;
    int ph_lo, ph_hi;
};

__device__ __forceinline__ unsigned cvt_pk_bf16(float lo, float hi) { unsigned r; asm volatile("v_cvt_pk_bf16_f32 %0, %1, %2" : "=v"(r) : "v"(lo), "v"(hi)); return r; }
__device__ __forceinline__ float bf_lo(unsigned w) { return __uint_as_float(w << 16); }
__device__ __forceinline__ float bf_hi(unsigned w) { return __uint_as_float(w & 0xffff0000u); }
__device__ __forceinline__ float bf2f(bf16_t b) { return __uint_as_float(((unsigned)b) << 16); }
__device__ __forceinline__ bf16_t f2bf(float f) { return (bf16_t)(cvt_pk_bf16(f, 0.f) & 0xffffu); }
__device__ __forceinline__ float gelu_tanh(float x) { const float u = x * (-2.302208198f - 0.1029432397f * x * x); return x * __builtin_amdgcn_rcpf(1.f + __builtin_amdgcn_exp2f(u)); }
__device__ __forceinline__ float sigmoidf_(float x) { return __builtin_amdgcn_rcpf(1.f + __builtin_amdgcn_exp2f(-1.4426950408889634f * x)); }
__device__ __forceinline__ float shflx(float v, int k, int lane) { return __int_as_float(__builtin_amdgcn_ds_bpermute((lane ^ k) << 2, __float_as_int(v))); }
__device__ __forceinline__ float wave_sum(float v, int lane) { for (int o = 32; o >= 1; o >>= 1) v += shflx(v, o, lane); return v; }

namespace pg8 {
constexpr int BM = 256, BK = 64, HALF = 128, HTB = HALF * BK * 2, STAGE_BYTES = 8 * HTB, NXCD = 8, WGM = 4;
constexpr bool SP2 = true;
constexpr bool ALIGN_EPI = true;
__host__ __device__ __forceinline__ int lds_byte(int r, int c) { const int st = (r >> 4) * 2 + (c >> 5), rr = r & 15, cc = c & 31, ob = rr * 64 + cc * 2; return st * 1024 + (ob ^ (((ob >> 9) & 1) << 5)); }
__host__ __device__ __forceinline__ void stage_rc(int b, int& R, int& C) { const int st = b / 1024, sb = b % 1024, swz = sb ^ (((sb >> 9) & 1) << 5); R = (st >> 1) * 16 + swz / 64; C = (st & 1) * 32 + (swz % 64) / 2; }
__host__ __device__ __forceinline__ int perm32(int rho) { const int n = rho >> 4, i = rho & 15; return 8 * (i >> 2) + 4 * n + (i & 3); }
struct Unit { int pm, pn; };
struct Gemm { const bf16_t* A; const bf16_t* Bt; int M, N, K; const bf16_t* A2; const bf16_t* Bt2; };
struct StaticOrder {
    int nM, nN, nwg, G, c, rev;
    __device__ void init(int M_, int N_, int G_, int c_, int rev_ = 0) { nM = M_ / BM; nN = N_ / BM; nwg = nM * nN; G = G_; c = c_; rev = rev_; }
    __device__ bool next(int i, Unit& u) const {
        const int nr = (nwg + G - 1) / G; if (i >= nr) return false;
        const long L = (long)(rev ? nr - 1 - i : i) * G + c; if (L >= nwg) return false;
        int wgid = (int)L; { const int q = nwg / NXCD, r = nwg % NXCD, xcd = wgid % NXCD, off = wgid / NXCD; wgid = (xcd < r ? xcd * (q + 1) : r * (q + 1) + (xcd - r) * q) + off; }
        const int nig = WGM * nN, gid = wgid / nig, fm = gid * WGM, gsz = (nM - fm) < WGM ? (nM - fm) : WGM;
        u.pm = fm + ((wgid % nig) % gsz); u.pn = (wgid % nig) / gsz; return true;
    }
};

template <class Epi>
__device__ __forceinline__ void gemm_phase(LAS unsigned char* lds, const Gemm g, const StaticOrder& S, const Epi& E, const int tid) {
    const int wid = __builtin_amdgcn_readfirstlane(tid >> 6), lane = tid & 63, wr = wid >> 2, wc = wid & 3, fr = lane & 15, fq = lane >> 4;
    const int K = g.K, nt = K / BK, ntt = Epi::TWO ? 2 * nt : nt;
    unsigned voffA[2], voffB[2];
#pragma unroll
    for (int i = 0; i < 2; ++i) { int R, C; stage_rc(tid * 16 + i * 8192, R, C); const int Rb = (R >> 5) * 64 + ((R >> 2) & 3) * 16 + ((R >> 4) & 1) * 4 + (R & 3);
        voffA[i] = (unsigned)(R * K + C) * 2u; voffB[i] = (unsigned)(Rb * K + C) * 2u; }
    const size_t kstep = (size_t)(BK * 2);
    const size_t hstep = (size_t)HALF * K * 2;
    const size_t tstep = 2 * hstep;
    const size_t bhs = (size_t)8 * K * 2;
    const unsigned ldsw = (unsigned)wid * 1024u;
    const int aoff = lds_byte(wr * 64 + fr, fq * 8), boff = lds_byte(wc * 32 + fr, fq * 8);
#define PG8_SA(b, h) (((b) * 2 + (h)) * HTB)
#define PG8_SB(b, h) ((4 + (b) * 2 + (h)) * HTB)
#define PG8_STAGE(bufoff, gbase, voff) do { _Pragma("unroll") for (int _i = 0; _i < 2; ++_i) \
        __builtin_amdgcn_global_load_lds((const unsigned*)((const char*)(gbase) + (voff)[_i]), (LAS unsigned*)(lds + (bufoff) + ldsw + _i * 8192), 16, 0, 0); } while (0)
#define PG8_LDA(dst, b, h) do { _Pragma("unroll") for (int m = 0; m < 4; ++m) _Pragma("unroll") for (int k = 0; k < 2; ++k) dst[m][k] = *(const LAS bf16x8*)(lds + PG8_SA(b, h) + aoff + m * 2048 + k * 1024); } while (0)
#define PG8_LDB(dst, b, h) do { _Pragma("unroll") for (int n = 0; n < 2; ++n) _Pragma("unroll") for (int k = 0; k < 2; ++k) dst[n][k] = *(const LAS bf16x8*)(lds + PG8_SB(b, h) + boff + n * 2048 + k * 1024); } while (0)
#define PG8_MMA(ai, bj, At, Bt) do { __builtin_amdgcn_s_setprio(1); _Pragma("unroll") for (int m = 0; m < 4; ++m) _Pragma("unroll") for (int n = 0; n < 2; ++n) _Pragma("unroll") for (int k = 0; k < 2; ++k) \
        acc[ai][bj][m][n] = __builtin_amdgcn_mfma_f32_16x16x32_bf16(Bt[n][k], At[m][k], acc[ai][bj][m][n], 0, 0, 0); __builtin_amdgcn_s_setprio(0); } while (0)
#define PG8_WAIT_V(n) asm volatile("s_waitcnt vmcnt(" #n ")" ::: "memory")
#define PG8_WAIT_L(n) asm volatile("s_waitcnt lgkmcnt(" #n ")" ::: "memory")
#define PG8_BAR __builtin_amdgcn_s_barrier()
#define PG8_SCHED __builtin_amdgcn_sched_barrier(0)
    Unit cur, nxt; int ui = 0;
    if (!S.next(0, cur)) return;
    E.prepare(cur, lds, 0, tid);
    f32x4 acc[2][2][4][2];
#pragma unroll
    for (int a = 0; a < 2; ++a)
#pragma unroll
        for (int b = 0; b < 2; ++b)
#pragma unroll
            for (int m = 0; m < 4; ++m)
#pragma unroll
                for (int n = 0; n < 2; ++n) acc[a][b][m][n] = (f32x4){0.f, 0.f, 0.f, 0.f};
    bf16x8 At[4][2], B0[2][2], B1[2][2];
    const char* cA = (const char*)g.A + (size_t)cur.pm * tstep; const char* cB = (const char*)g.Bt + (size_t)cur.pn * tstep;
    const char* cA2 = Epi::TWO ? (const char*)g.A2 + (size_t)cur.pm * tstep : cA; const char* cB2 = Epi::TWO ? (const char*)g.Bt2 + (size_t)cur.pn * tstep : cB;
    if constexpr (SP2) {
        PG8_STAGE(PG8_SB(0, 0), cB, voffB); PG8_STAGE(PG8_SB(0, 1), cB + bhs, voffB); PG8_STAGE(PG8_SA(0, 0), cA, voffA); PG8_STAGE(PG8_SA(0, 1), cA + hstep, voffA);
        if (wr == 1) PG8_BAR;
        PG8_WAIT_V(2); PG8_BAR;
        PG8_STAGE(PG8_SB(1, 0), cB + kstep, voffB); PG8_STAGE(PG8_SA(1, 0), cA + kstep, voffA); PG8_STAGE(PG8_SB(1, 1), cB + bhs + kstep, voffB);
        PG8_WAIT_V(6); PG8_BAR;
    } else {
        PG8_STAGE(PG8_SB(0, 0), cB, voffB); PG8_STAGE(PG8_SA(0, 0), cA, voffA); PG8_STAGE(PG8_SB(0, 1), cB + bhs, voffB); PG8_STAGE(PG8_SA(0, 1), cA + hstep, voffA);
        if (wr == 1) PG8_BAR;
        PG8_WAIT_V(4); PG8_BAR;
        PG8_STAGE(PG8_SB(1, 0), cB + kstep, voffB); PG8_STAGE(PG8_SA(1, 0), cA + kstep, voffA); PG8_STAGE(PG8_SB(1, 1), cB + bhs + kstep, voffB);
        PG8_WAIT_V(6); PG8_BAR;
    }
    for (;;) {
        const bool has_next = S.next(ui + 1, nxt);
        const char* nA = has_next ? (const char*)g.A + (size_t)nxt.pm * tstep : cA; const char* nB = has_next ? (const char*)g.Bt + (size_t)nxt.pn * tstep : cB;
        for (int t = 0; t < ntt; t += 2) {
            const bool last = (t == ntt - 2);
            const bool s1 = Epi::TWO && (t >= nt), s2 = Epi::TWO && (t + 2 >= nt);
            const char* a1 = (s1 ? cA2 + (size_t)(t - nt + 1) * kstep : cA + (size_t)(t + 1) * kstep);
            const char* a2 = last ? nA : (s2 ? cA2 + (size_t)(t + 2 - nt) * kstep : cA + (size_t)(t + 2) * kstep);
            const char* b2 = last ? nB : (s2 ? cB2 + (size_t)(t + 2 - nt) * kstep : cB + (size_t)(t + 2) * kstep);
            const char* a3 = a2 + kstep; const char* b3 = b2 + kstep;
            if constexpr (Epi::TWO) { if (t == nt) E.mid(acc, cur, wr, wc, fr, fq); }
            if constexpr (SP2) {
            PG8_LDB(B0, 0, 0); PG8_LDB(B1, 0, 1); PG8_SCHED; PG8_LDA(At, 0, 0); PG8_STAGE(PG8_SA(1, 1), a1 + hstep, voffA);
            PG8_WAIT_V(8); PG8_WAIT_L(0); PG8_BAR; PG8_MMA(0, 0, At, B0); PG8_MMA(0, 1, At, B1); PG8_BAR; PG8_SCHED;
            PG8_LDA(At, 0, 1); PG8_STAGE(PG8_SB(0, 0), b2, voffB); PG8_STAGE(PG8_SB(0, 1), b2 + bhs, voffB); PG8_STAGE(PG8_SA(0, 0), a2, voffA);
            PG8_WAIT_V(8); PG8_WAIT_L(0); PG8_BAR; PG8_MMA(1, 0, At, B0); PG8_MMA(1, 1, At, B1); PG8_BAR; PG8_SCHED;
            PG8_LDB(B0, 1, 0); PG8_LDB(B1, 1, 1); PG8_SCHED; PG8_LDA(At, 1, 0); PG8_STAGE(PG8_SA(0, 1), a2 + hstep, voffA);
            PG8_WAIT_V(8); PG8_WAIT_L(0); PG8_BAR; PG8_MMA(0, 0, At, B0); PG8_MMA(0, 1, At, B1); PG8_BAR; PG8_SCHED;
            PG8_LDA(At, 1, 1); PG8_STAGE(PG8_SB(1, 0), b3, voffB); PG8_STAGE(PG8_SB(1, 1), b3 + bhs, voffB); PG8_STAGE(PG8_SA(1, 0), a3, voffA);
            PG8_WAIT_V(8); PG8_WAIT_L(0); PG8_BAR; PG8_MMA(1, 0, At, B0); PG8_MMA(1, 1, At, B1); PG8_BAR; PG8_SCHED;
            } else {
            PG8_LDB(B0, 0, 0); PG8_SCHED; PG8_LDA(At, 0, 0); PG8_STAGE(PG8_SA(1, 1), a1 + hstep, voffA);
            PG8_WAIT_L(8); PG8_BAR; PG8_WAIT_L(0); PG8_MMA(0, 0, At, B0); PG8_BAR; PG8_SCHED;
            PG8_LDB(B1, 0, 1); PG8_STAGE(PG8_SB(0, 0), b2, voffB);
            PG8_BAR; PG8_WAIT_L(0); PG8_MMA(0, 1, At, B1); PG8_BAR;
            PG8_LDA(At, 0, 1); PG8_STAGE(PG8_SA(0, 0), a2, voffA);
            PG8_BAR; PG8_WAIT_L(0); PG8_MMA(1, 0, At, B0); PG8_BAR; PG8_SCHED;
            PG8_STAGE(PG8_SB(0, 1), b2 + bhs, voffB);
            PG8_WAIT_V(6); PG8_BAR; PG8_MMA(1, 1, At, B1); PG8_BAR;
            PG8_LDB(B0, 1, 0); PG8_SCHED; PG8_LDA(At, 1, 0); PG8_STAGE(PG8_SA(0, 1), a2 + hstep, voffA);
            PG8_WAIT_L(8); PG8_BAR; PG8_WAIT_L(0); PG8_MMA(0, 0, At, B0); PG8_BAR; PG8_SCHED;
            PG8_LDB(B1, 1, 1); PG8_STAGE(PG8_SB(1, 0), b3, voffB);
            PG8_BAR; PG8_WAIT_L(0); PG8_MMA(0, 1, At, B1); PG8_BAR;
            PG8_LDA(At, 1, 1); PG8_STAGE(PG8_SA(1, 0), a3, voffA);
            PG8_BAR; PG8_WAIT_L(0); PG8_MMA(1, 0, At, B0); PG8_BAR; PG8_SCHED;
            PG8_STAGE(PG8_SB(1, 1), b3 + bhs, voffB);
            PG8_WAIT_V(6); PG8_BAR; PG8_MMA(1, 1, At, B1); PG8_BAR;
            }
        }
        if (ALIGN_EPI) { if (wr == 0) PG8_BAR; }
        E(acc, cur, wr, wc, fr, fq, lds, ui & 1);
        if (!has_next) break;
#pragma unroll
        for (int a = 0; a < 2; ++a)
#pragma unroll
            for (int b = 0; b < 2; ++b)
#pragma unroll
                for (int m = 0; m < 4; ++m)
#pragma unroll
                    for (int n = 0; n < 2; ++n) acc[a][b][m][n] = (f32x4){0.f, 0.f, 0.f, 0.f};
        cur = nxt; cA = nA; cB = nB; ++ui;
        if (Epi::TWO) { cA2 = (const char*)g.A2 + (size_t)cur.pm * tstep; cB2 = (const char*)g.Bt2 + (size_t)cur.pn * tstep; }
        E.prepare(cur, lds, ui & 1, tid);
        if (ALIGN_EPI) { if (wr == 1) PG8_BAR; }
    }
    PG8_WAIT_V(0);
    if (!ALIGN_EPI) { if (wr == 0) PG8_BAR; }
    PG8_BAR;
#undef PG8_SA
#undef PG8_SB
#undef PG8_STAGE
#undef PG8_LDA
#undef PG8_LDB
#undef PG8_MMA
#undef PG8_WAIT_V
#undef PG8_WAIT_L
#undef PG8_BAR
#undef PG8_SCHED
}
}

__device__ __forceinline__ u32x4 pack8(const f32x4 a, const f32x4 b) { u32x4 w; w.x = cvt_pk_bf16(a[0], a[1]); w.y = cvt_pk_bf16(a[2], a[3]); w.z = cvt_pk_bf16(b[0], b[1]); w.w = cvt_pk_bf16(b[2], b[3]); return w; }


struct Fold {
    const float* stats;
    const float* cs;
    int N;
    __device__ __forceinline__ void prepare(const pg8::Unit& u, LAS unsigned char* lds, int par, int tid) const {
        if (stats == nullptr) return;
        const int h = tid >> 8, tt = tid & 255, rl = tt >> 1, part = tt & 1, lrow = (rl >> 6) * 128 + h * 64 + (rl & 63);
        const float* sp = stats + ((size_t)(u.pm * 256 + lrow) * 32 + part * 16) * 2;
        float s1 = 0.f, s2 = 0.f;
#pragma unroll
        for (int i = 0; i < 8; ++i) { const f32x4 v = *(const f32x4*)(sp + 4 * i); s1 += v[0] + v[2]; s2 += v[1] + v[3]; }
        s1 += shflx(s1, 1, tid & 63); s2 += shflx(s2, 1, tid & 63);
        const float mu = s1 * (1.f / D), var = s2 * (1.f / D) - mu * mu, rstd = __builtin_amdgcn_rsqf(var + LN_EPS);
        if (part == 0) { LAS float* rs = (LAS float*)(lds + RS_OFF) + (par * 256 + lrow) * 2; rs[0] = mu; rs[1] = rstd; }
        if (cs != nullptr) {
            const int col = u.pn * 256 + tt;
            const float c = (cs[col] + cs[N + col]) + (cs[2 * N + col] + cs[3 * N + col]);
            const float b = (cs[4 * N + col] + cs[5 * N + col]) + (cs[6 * N + col] + cs[7 * N + col]);
            LAS float* cv = (LAS float*)(lds + CV_OFF) + ((par * 2 + h) * 256 + tt) * 2; cv[0] = c; cv[1] = b;
        }
    }
};
__device__ __forceinline__ void fold_apply(f32x4& v0, f32x4& v1, float mu, float rstd, const LAS float* cv, int lc) {
    const f32x4 c0 = *(const LAS f32x4*)(cv + 2 * lc), c1 = *(const LAS f32x4*)(cv + 2 * lc + 4), c2 = *(const LAS f32x4*)(cv + 2 * lc + 8), c3 = *(const LAS f32x4*)(cv + 2 * lc + 12);
    const float rm = rstd * mu;
    v0[0] = rstd * v0[0] - rm * c0[0] + c0[1]; v0[1] = rstd * v0[1] - rm * c0[2] + c0[3]; v0[2] = rstd * v0[2] - rm * c1[0] + c1[1]; v0[3] = rstd * v0[3] - rm * c1[2] + c1[3];
    v1[0] = rstd * v1[0] - rm * c2[0] + c2[1]; v1[1] = rstd * v1[1] - rm * c2[2] + c2[3]; v1[2] = rstd * v1[2] - rm * c3[0] + c3[1]; v1[3] = rstd * v1[3] - rm * c3[2] + c3[3];
}

struct EpiIn {
    static constexpr bool PERM = true, TWO = false;
    bf16_t *gu, *gv, *q, *kb, *vb, *sa, *sb; const float* bgate; const float* rope; float* statsv; Fold F;
    __device__ __forceinline__ void prepare(const pg8::Unit& u, LAS unsigned char* lds, int par, int tid) const { F.prepare(u, lds, par, tid); }
    __device__ __forceinline__ void operator()(const f32x4 (&acc)[2][2][4][2], const pg8::Unit& u, int wr, int wc, int fr, int fq, LAS unsigned char* lds, int par) const {
        const bool fold = F.stats != nullptr;
        const LAS float* rsb = (const LAS float*)(lds + RS_OFF) + par * 512; const LAS float* cvb = (const LAS float*)(lds + CV_OFF) + (par * 2 + wr) * 512;
        const int pn = u.pn, row0 = u.pm * 256 + wr * 64 + fr, cl = wc * 64 + 16 * fq;
        int kind, ld, ct; bf16_t* base;
        if (pn < 4) { kind = 0; base = gu; ld = GW; ct = pn * 256; }
        else if (pn < 8) { kind = 0; base = gv; ld = GW; ct = (pn - 4) * 256; }
        else if (pn < 12) { kind = 1; base = q; ld = AW; ct = (pn - 8) * 256; }
        else if (pn == 12) { kind = 2; base = kb; ld = KVW; ct = 0; }
        else if (pn == 13) { kind = 3; base = vb; ld = KVW; ct = 0; }
        else if (pn < 22) { kind = 4; base = sa; ld = D; ct = (pn - 14) * 256; }
        else { kind = 4; base = sb; ld = D; ct = (pn - 22) * 256; }
        const int gcol = (pn - 14) * 256;
#pragma unroll
        for (int ai = 0; ai < 2; ++ai)
#pragma unroll
            for (int m = 0; m < 4; ++m) {
                const int row = row0 + ai * 128 + m * 16, lrow = ai * 128 + wr * 64 + m * 16 + fr;
                float mu = 0.f, rstd = 1.f; if (fold) { mu = rsb[2 * lrow]; rstd = rsb[2 * lrow + 1]; }
                float s1 = 0.f, s2 = 0.f;
#pragma unroll
                for (int bj = 0; bj < 2; ++bj) {
                    const int c = cl + bj * 8;
                    f32x4 v0 = acc[ai][bj][m][0], v1 = acc[ai][bj][m][1];
                    if (fold) fold_apply(v0, v1, mu, rstd, cvb, c);
                    if (kind == 0) {
#pragma unroll
                        for (int j = 0; j < 4; ++j) { v0[j] = gelu_tanh(v0[j]); v1[j] = gelu_tanh(v1[j]); }
                    } else if (kind == 1 || kind == 2) {
                        const int pos = row & (SEQ - 1), i0 = (c & 63) >> 1;
                        const f32x4 r0 = *(const f32x4*)(rope + ((size_t)pos * 32 + i0) * 2), r1 = *(const f32x4*)(rope + ((size_t)pos * 32 + i0 + 2) * 2);
                        const float sc = (kind == 1) ? 0.125f : 1.0f;
                        f32x4 o0, o1;
                        o0[0] = (v0[0] * r0[0] - v0[1] * r0[1]) * sc; o0[1] = (v0[1] * r0[0] + v0[0] * r0[1]) * sc;
                        o0[2] = (v0[2] * r0[2] - v0[3] * r0[3]) * sc; o0[3] = (v0[3] * r0[2] + v0[2] * r0[3]) * sc;
                        o1[0] = (v1[0] * r1[0] - v1[1] * r1[1]) * sc; o1[1] = (v1[1] * r1[0] + v1[0] * r1[1]) * sc;
                        o1[2] = (v1[2] * r1[2] - v1[3] * r1[3]) * sc; o1[3] = (v1[3] * r1[2] + v1[2] * r1[3]) * sc;
                        v0 = o0; v1 = o1;
                    } else if (kind == 4) {
                        const f32x4 b0 = *(const f32x4*)(bgate + gcol + c), b1 = *(const f32x4*)(bgate + gcol + c + 4);
#pragma unroll
                        for (int j = 0; j < 4; ++j) { v0[j] = sigmoidf_(v0[j] + b0[j]); v1[j] = sigmoidf_(v1[j] + b1[j]); }
                    }
                    const u32x4 pw = pack8(v0, v1);
                    *(u32x4*)(base + (size_t)row * ld + ct + c) = pw;
                    if (kind == 0 && pn >= 4) {
                        const float a0 = bf_lo(pw.x), a1 = bf_hi(pw.x), a2 = bf_lo(pw.y), a3 = bf_hi(pw.y), a4 = bf_lo(pw.z), a5 = bf_hi(pw.z), a6 = bf_lo(pw.w), a7 = bf_hi(pw.w);
                        s1 += ((a0 + a1) + (a2 + a3)) + ((a4 + a5) + (a6 + a7));
                        s2 += ((a0 * a0 + a1 * a1) + (a2 * a2 + a3 * a3)) + ((a4 * a4 + a5 * a5) + (a6 * a6 + a7 * a7));
                    }
                }
                if (kind == 0 && pn >= 4) {
                    s1 += shflx(s1, 16, fr + 16 * fq); s1 += shflx(s1, 32, fr + 16 * fq); s2 += shflx(s2, 16, fr + 16 * fq); s2 += shflx(s2, 32, fr + 16 * fq);
                    if (fq == 0) { float* sp = statsv + ((size_t)row * 16 + (pn - 4) * 4 + wc) * 2; sp[0] = s1; sp[1] = s2; }
                }
            }
    }
};
template <int MODE> struct EpiB {
    static constexpr bool PERM = true, TWO = false;
    bf16_t* o; int ld; float scale; const bf16_t* gate; Fold F;
    __device__ __forceinline__ void prepare(const pg8::Unit& u, LAS unsigned char* lds, int par, int tid) const { F.prepare(u, lds, par, tid); }
    __device__ __forceinline__ void operator()(const f32x4 (&acc)[2][2][4][2], const pg8::Unit& u, int wr, int wc, int fr, int fq, LAS unsigned char* lds, int par) const {
        const bool fold = F.stats != nullptr;
        const LAS float* rsb = (const LAS float*)(lds + RS_OFF) + par * 512; const LAS float* cvb = (const LAS float*)(lds + CV_OFF) + (par * 2 + wr) * 512;
        const int row0 = u.pm * 256 + wr * 64 + fr, c0 = u.pn * 256 + wc * 64 + 16 * fq;
#pragma unroll
        for (int ai = 0; ai < 2; ++ai)
#pragma unroll
            for (int m = 0; m < 4; ++m) {
                const int row = row0 + ai * 128 + m * 16, lrow = ai * 128 + wr * 64 + m * 16 + fr;
                float mu = 0.f, rstd = 1.f; if (fold) { mu = rsb[2 * lrow]; rstd = rsb[2 * lrow + 1]; }
#pragma unroll
                for (int bj = 0; bj < 2; ++bj) {
                    const size_t off = (size_t)row * ld + c0 + bj * 8;
                    f32x4 v0 = acc[ai][bj][m][0], v1 = acc[ai][bj][m][1];
                    if (fold) fold_apply(v0, v1, mu, rstd, cvb, wc * 64 + 16 * fq + bj * 8);
                    if (MODE == 0) { v0 *= scale; v1 *= scale; }
                    if (MODE == 1) {
#pragma unroll
                        for (int j = 0; j < 4; ++j) { const float a = fmaxf(v0[j], 0.f), b = fmaxf(v1[j], 0.f); v0[j] = a * a; v1[j] = b * b; }
                    }
                    if (MODE == 2 || MODE == 3) {
                        const u32x4 gw = *(const u32x4*)(gate + off);
                        v0[0] *= bf_lo(gw.x); v0[1] *= bf_hi(gw.x); v0[2] *= bf_lo(gw.y); v0[3] *= bf_hi(gw.y);
                        v1[0] *= bf_lo(gw.z); v1[1] *= bf_hi(gw.z); v1[2] *= bf_lo(gw.w); v1[3] *= bf_hi(gw.w);
                    }
                    if (MODE == 3) {
                        const u32x4 pw = *(const u32x4*)(o + off);
                        v0[0] += bf_lo(pw.x); v0[1] += bf_hi(pw.x); v0[2] += bf_lo(pw.y); v0[3] += bf_hi(pw.y);
                        v1[0] += bf_lo(pw.z); v1[1] += bf_hi(pw.z); v1[2] += bf_lo(pw.w); v1[3] += bf_hi(pw.w);
                    }
                    *(u32x4*)(o + off) = pack8(v0, v1);
                }
            }
    }
};
struct EpiBR {
    static constexpr bool PERM = true, TWO = true;
    bf16_t* o; const bf16_t* sa; const bf16_t* sb;
    __device__ __forceinline__ void prepare(const pg8::Unit&, LAS unsigned char*, int, int) const {}
    __device__ __forceinline__ void mid(f32x4 (&acc)[2][2][4][2], const pg8::Unit& u, int wr, int wc, int fr, int fq) const {
        int row0 = u.pm * 256 + wr * 64 + fr, c0 = u.pn * 256 + wc * 64 + 16 * fq;
        asm volatile("" : "+v"(row0), "+v"(c0));
#pragma unroll
        for (int ai = 0; ai < 2; ++ai)
#pragma unroll
            for (int m = 0; m < 4; ++m)
#pragma unroll
                for (int bj = 0; bj < 2; ++bj) {
                    const size_t off = (size_t)(row0 + ai * 128 + m * 16) * D + c0 + bj * 8;
                    const u32x4 a = *(const u32x4*)(sa + off), b = *(const u32x4*)(sb + off);
                    f32x4 r0, r1;
                    r0[0] = bf_lo(a.x) * __builtin_amdgcn_rcpf(bf_lo(b.x)); r0[1] = bf_hi(a.x) * __builtin_amdgcn_rcpf(bf_hi(b.x)); r0[2] = bf_lo(a.y) * __builtin_amdgcn_rcpf(bf_lo(b.y)); r0[3] = bf_hi(a.y) * __builtin_amdgcn_rcpf(bf_hi(b.y));
                    r1[0] = bf_lo(a.z) * __builtin_amdgcn_rcpf(bf_lo(b.z)); r1[1] = bf_hi(a.z) * __builtin_amdgcn_rcpf(bf_hi(b.z)); r1[2] = bf_lo(a.w) * __builtin_amdgcn_rcpf(bf_lo(b.w)); r1[3] = bf_hi(a.w) * __builtin_amdgcn_rcpf(bf_hi(b.w));
                    acc[ai][bj][m][0] *= r0; acc[ai][bj][m][1] *= r1;
                    if ((m & 1) && bj == 1) asm volatile("" ::: "memory");
                }
    }
    __device__ __forceinline__ void operator()(const f32x4 (&acc)[2][2][4][2], const pg8::Unit& u, int wr, int wc, int fr, int fq, LAS unsigned char*, int) const {
        const int row0 = u.pm * 256 + wr * 64 + fr, c0 = u.pn * 256 + wc * 64 + 16 * fq;
#pragma unroll
        for (int ai = 0; ai < 2; ++ai)
#pragma unroll
            for (int m = 0; m < 4; ++m)
#pragma unroll
                for (int bj = 0; bj < 2; ++bj) {
                    const size_t off = (size_t)(row0 + ai * 128 + m * 16) * D + c0 + bj * 8;
                    const u32x4 b = *(const u32x4*)(sb + off);
                    f32x4 v0 = acc[ai][bj][m][0], v1 = acc[ai][bj][m][1];
                    v0[0] *= bf_lo(b.x); v0[1] *= bf_hi(b.x); v0[2] *= bf_lo(b.y); v0[3] *= bf_hi(b.y);
                    v1[0] *= bf_lo(b.z); v1[1] *= bf_hi(b.z); v1[2] *= bf_lo(b.w); v1[3] *= bf_hi(b.w);
                    *(u32x4*)(o + off) = pack8(v0, v1);
                }
    }
};
struct EpiRes {
    static constexpr bool PERM = true, TWO = false;
    const float* xin; float* xout; bf16_t* tb; const float* pg; const float* pb; float* stats_out; Fold F;
    __device__ __forceinline__ void prepare(const pg8::Unit& u, LAS unsigned char* lds, int par, int tid) const { F.prepare(u, lds, par, tid); }
    __device__ __forceinline__ void operator()(const f32x4 (&acc)[2][2][4][2], const pg8::Unit& u, int wr, int wc, int fr, int fq, LAS unsigned char* lds, int par) const {
        const bool prev = F.stats != nullptr;
        const LAS float* rsb = (const LAS float*)(lds + RS_OFF) + par * 512;
        const int row0 = u.pm * 256 + wr * 64 + fr, c0 = u.pn * 256 + wc * 64 + 16 * fq;
        f32x4 gg[4], bb[4];
        if (prev) {
#pragma unroll
            for (int i = 0; i < 4; ++i) { gg[i] = *(const f32x4*)(pg + c0 + 4 * i); bb[i] = *(const f32x4*)(pb + c0 + 4 * i); }
        }
#pragma unroll
        for (int ai = 0; ai < 2; ++ai)
#pragma unroll
            for (int m = 0; m < 4; ++m) {
                const int row = row0 + ai * 128 + m * 16, lrow = ai * 128 + wr * 64 + m * 16 + fr;
                const size_t ro = (size_t)row * D + c0;
                float mu = 0.f, rstd = 1.f; if (prev) { mu = rsb[2 * lrow]; rstd = rsb[2 * lrow + 1]; }
                float s1 = 0.f, s2 = 0.f;
#pragma unroll
                for (int bj = 0; bj < 2; ++bj) {
                    f32x4 r0, r1;
                    if (prev) {
                        const u32x4 w = *(const u32x4*)(tb + ro + bj * 8);
                        r0 = (f32x4){bf_lo(w.x), bf_hi(w.x), bf_lo(w.y), bf_hi(w.y)}; r1 = (f32x4){bf_lo(w.z), bf_hi(w.z), bf_lo(w.w), bf_hi(w.w)};
                        r0 = (r0 - mu) * rstd * gg[2 * bj] + bb[2 * bj]; r1 = (r1 - mu) * rstd * gg[2 * bj + 1] + bb[2 * bj + 1];
                    } else { r0 = *(const f32x4*)(xin + ro + bj * 8); r1 = *(const f32x4*)(xin + ro + bj * 8 + 4); }
                    const f32x4 t0 = r0 * ALPHA + acc[ai][bj][m][0], t1 = r1 * ALPHA + acc[ai][bj][m][1];
                    if (xout != nullptr) { *(f32x4*)(xout + ro + bj * 8) = t0; *(f32x4*)(xout + ro + bj * 8 + 4) = t1; }
                    const u32x4 pw = pack8(t0, t1);
                    *(u32x4*)(tb + ro + bj * 8) = pw;
                    const float a0 = bf_lo(pw.x), a1 = bf_hi(pw.x), a2 = bf_lo(pw.y), a3 = bf_hi(pw.y), a4 = bf_lo(pw.z), a5 = bf_hi(pw.z), a6 = bf_lo(pw.w), a7 = bf_hi(pw.w);
                    s1 += ((a0 + a1) + (a2 + a3)) + ((a4 + a5) + (a6 + a7));
                    s2 += ((a0 * a0 + a1 * a1) + (a2 * a2 + a3 * a3)) + ((a4 * a4 + a5 * a5) + (a6 * a6 + a7 * a7));
                }
                s1 += shflx(s1, 16, fr + 16 * fq); s1 += shflx(s1, 32, fr + 16 * fq); s2 += shflx(s2, 16, fr + 16 * fq); s2 += shflx(s2, 32, fr + 16 * fq);
                if (fq == 0) { float* sp = stats_out + ((size_t)row * 32 + u.pn * 4 + wc) * 2; sp[0] = s1; sp[1] = s2; }
            }
    }
};

template <bool FOLD>
__device__ __forceinline__ void conv_wt_t(const float* __restrict__ W, bf16_t* __restrict__ Wt, int K, int N, bool ropeperm, const float* __restrict__ gvec, const float* __restrict__ bvec,
                                          float* __restrict__ csP, LAS float* lds_f, const int tid, const int vbid, const int vG) {
    constexpr int TP = 257, TILE_F = 64 * TP + 60;
    if (vbid < 0) return;
    const int G = vG, bid = vbid, ntk = K >> 6, nt_all = ntk * (N >> 8), nunits = (N >> 8) * 4, u0 = vbid;
    const int lk = tid >> 6, ln4 = (tid & 63) << 2, n = tid >> 1, par = tid & 1;
    float csum = 0.f, bsum = 0.f;
#define CW_COORD(j, valid, k0, n0) do { if (FOLD) { const int _u = u0 + ((j) >> 3) * G; valid = _u < nunits; n0 = (_u >> 2) << 8; k0 = (_u & 3) * 512 + ((j) & 7) * 64; } \
                                        else { const int _t = bid + (j) * G; valid = _t < nt_all; k0 = (_t % ntk) << 6; n0 = (_t / ntk) << 8; } } while (0)
#define CW_LOAD(v, j) do { bool _ok; int _k0, _n0; CW_COORD(j, _ok, _k0, _n0); if (_ok) { _Pragma("unroll") for (int i = 0; i < 8; ++i) v[i] = __builtin_nontemporal_load((const f32x4*)(W + (size_t)(_k0 + lk + 8 * i) * N + _n0 + ln4)); } } while (0)
#define CW_PROC(v, j, buf) do { bool _ok; int k0, n0; CW_COORD(j, _ok, k0, n0); if (!_ok) break; \
        LAS float* tile = lds_f + (buf) * TILE_F; \
        _Pragma("unroll") for (int i = 0; i < 8; ++i) { LAS float* tp = tile + (lk + 8 * i) * TP + ln4; tp[0] = v[i][0]; tp[1] = v[i][1]; tp[2] = v[i][2]; tp[3] = v[i][3]; } \
        __syncthreads(); \
        CW_LOAD(v, (j) + 2); \
        int nd = n0 + n; \
        if (ropeperm && nd >= 2048 && nd < 3328) { const int d = nd & 63; nd = nd - d + (d < 32 ? 2 * d : 2 * (d - 32) + 1); } \
        _Pragma("unroll") for (int jj = 0; jj < 4; ++jj) { \
            const int c = par + 2 * jj; const LAS float* tp = tile + (8 * c) * TP + n; \
            float w0 = tp[0 * TP], w1 = tp[1 * TP], w2 = tp[2 * TP], w3 = tp[3 * TP], w4 = tp[4 * TP], w5 = tp[5 * TP], w6 = tp[6 * TP], w7 = tp[7 * TP]; \
            if (FOLD) { \
                const f32x4 g0 = *(const f32x4*)(gvec + k0 + 8 * c), g1 = *(const f32x4*)(gvec + k0 + 8 * c + 4), b0 = *(const f32x4*)(bvec + k0 + 8 * c), b1 = *(const f32x4*)(bvec + k0 + 8 * c + 4); \
                bsum += ((w0 * b0[0] + w1 * b0[1]) + (w2 * b0[2] + w3 * b0[3])) + ((w4 * b1[0] + w5 * b1[1]) + (w6 * b1[2] + w7 * b1[3])); \
                w0 *= g0[0]; w1 *= g0[1]; w2 *= g0[2]; w3 *= g0[3]; w4 *= g1[0]; w5 *= g1[1]; w6 *= g1[2]; w7 *= g1[3]; } \
            u32x4 w; w.x = cvt_pk_bf16(w0, w1); w.y = cvt_pk_bf16(w2, w3); w.z = cvt_pk_bf16(w4, w5); w.w = cvt_pk_bf16(w6, w7); \
            *(u32x4*)(Wt + (size_t)nd * K + k0 + 8 * c) = w; \
            if (FOLD) csum += ((bf_lo(w.x) + bf_hi(w.x)) + (bf_lo(w.y) + bf_hi(w.y))) + ((bf_lo(w.z) + bf_hi(w.z)) + (bf_lo(w.w) + bf_hi(w.w))); } \
        if (FOLD && ((j) & 7) == 7) { \
            csum += shflx(csum, 1, tid & 63); bsum += shflx(bsum, 1, tid & 63); \
            if (par == 0) { const int q = (k0 >> 9); csP[(size_t)q * N + nd] = csum; csP[(size_t)(4 + q) * N + nd] = bsum; } \
            csum = 0.f; bsum = 0.f; } \
    } while (0)
    f32x4 va[8], vb[8];
    CW_LOAD(va, 0); CW_LOAD(vb, 1);
    for (int j = 0;; j += 2) {
        bool ok; int kk, nn; CW_COORD(j, ok, kk, nn); if (!ok) break;
        CW_PROC(va, j, 0);
        CW_PROC(vb, j + 1, 1);
    }
    __syncthreads();
#undef CW_COORD
#undef CW_LOAD
#undef CW_PROC
}
__device__ __forceinline__ void conv_wt(const float* __restrict__ W, bf16_t* __restrict__ Wt, int K, int N, bool ropeperm, LAS float* tile, const int tid, const int vbid, const int vG) {
    conv_wt_t<false>(W, Wt, K, N, ropeperm, nullptr, nullptr, nullptr, tile, tid, vbid, vG);
}
__device__ __forceinline__ void conv_wt_fold(const float* __restrict__ W, bf16_t* __restrict__ Wt, int N, bool ropeperm, const float* __restrict__ gvec, const float* __restrict__ bvec,
                                             float* __restrict__ csP, LAS float* tile, const int tid, const int vbid, const int vG) {
    conv_wt_t<true>(W, Wt, D, N, ropeperm, gvec, bvec, csP, tile, tid, vbid, vG);
}
__device__ __forceinline__ void cvt_bf16(const float* __restrict__ src, bf16_t* __restrict__ dst, size_t n, const int tid, const int bid) {
    for (size_t i = ((size_t)bid * 512 + tid) * 8; i < n; i += (size_t)gridDim.x * 512 * 8) {
        const f32x4 a = *(const f32x4*)(src + i), b = *(const f32x4*)(src + i + 4);
        *(u32x4*)(dst + i) = pack8(a, b);
    }
}
__device__ __forceinline__ void rope_table(float* tab, const int tid, const int bid) {
    for (int idx = bid * 512 + tid; idx < SEQ * 32; idx += gridDim.x * 512) {
        const int pos = idx >> 5, i = idx & 31;
        double invd = 1.0; for (int k = 0; k < i; ++k) invd *= 0.7498942093324558;
        const float ang = (float)pos * (float)invd;
        const double a = (double)ang, kq = __builtin_rint(a * 0.6366197723675814);
        const double r = (a - kq * 1.5707963267948966) - kq * 6.123233995736766e-17, r2 = r * r;
        const double sn = r * (1.0 + r2 * (-1.0 / 6 + r2 * (1.0 / 120 + r2 * (-1.0 / 5040 + r2 * (1.0 / 362880 + r2 * (-1.0 / 39916800 + r2 * (1.0 / 6227020800.0)))))));
        const double cs = 1.0 + r2 * (-0.5 + r2 * (1.0 / 24 + r2 * (-1.0 / 720 + r2 * (1.0 / 40320 + r2 * (-1.0 / 3628800 + r2 * (1.0 / 479001600 + r2 * (-1.0 / 87178291200.0)))))));
        const int qd = ((int)kq) & 3;
        const double s_ = (qd == 0) ? sn : (qd == 1) ? cs : (qd == 2) ? -sn : -cs;
        const double c_ = (qd == 0) ? cs : (qd == 1) ? -sn : (qd == 2) ? -cs : sn;
        tab[idx * 2] = (float)c_; tab[idx * 2 + 1] = (float)s_;
    }
}
__device__ __forceinline__ void ln_final(const bf16_t* tb, float* out, const float* __restrict__ g, const float* __restrict__ b, const int tid, const int bid) {
    const int wid = tid >> 6, lane = tid & 63;
    u32x4 wn[4];
    int row = bid * 8 + wid;
    if (row < M) {
#pragma unroll
        for (int i = 0; i < 4; ++i) wn[i] = *(const u32x4*)(tb + (size_t)row * D + i * 512 + lane * 8);
    }
    for (; row < M; row += gridDim.x * 8) {
        f32x4 v[8]; float s = 0.f;
#pragma unroll
        for (int i = 0; i < 4; ++i) {
            v[2 * i] = (f32x4){bf_lo(wn[i].x), bf_hi(wn[i].x), bf_lo(wn[i].y), bf_hi(wn[i].y)}; v[2 * i + 1] = (f32x4){bf_lo(wn[i].z), bf_hi(wn[i].z), bf_lo(wn[i].w), bf_hi(wn[i].w)};
            s += ((v[2 * i][0] + v[2 * i][1]) + (v[2 * i][2] + v[2 * i][3])) + ((v[2 * i + 1][0] + v[2 * i + 1][1]) + (v[2 * i + 1][2] + v[2 * i + 1][3]));
        }
        const int rn = row + gridDim.x * 8;
        if (rn < M) {
#pragma unroll
            for (int i = 0; i < 4; ++i) wn[i] = *(const u32x4*)(tb + (size_t)rn * D + i * 512 + lane * 8);
        }
        const float mean = wave_sum(s, lane) * (1.f / D); float q = 0.f;
#pragma unroll
        for (int i = 0; i < 8; ++i) { const f32x4 d = v[i] - mean; q += (d[0] * d[0] + d[1] * d[1]) + (d[2] * d[2] + d[3] * d[3]); }
        const float rstd = __builtin_amdgcn_rsqf(wave_sum(q, lane) * (1.f / D) + LN_EPS);
#pragma unroll
        for (int i = 0; i < 8; ++i) {
            const int c = (i >> 1) * 512 + lane * 8 + (i & 1) * 4;
            const f32x4 gg = *(const f32x4*)(g + c), bb = *(const f32x4*)(b + c);
            *(f32x4*)(out + (size_t)row * D + c) = (v[i] - mean) * rstd * gg + bb;
        }
    }
}
__device__ __forceinline__ bf16x8 as_bf16x8(u32x4 w) { union { u32x4 u; bf16x8 b; } x; x.u = w; return x.b; }
#define MFMA16(a, b, c) __builtin_amdgcn_mfma_f32_16x16x32_bf16((a), (b), (c), 0, 0, 0)

__device__ __forceinline__ void sgu_phase(const bf16_t* gu, const bf16_t* gv, const float* __restrict__ statsv, const float* __restrict__ lng, const float* __restrict__ lnb, const bf16_t* __restrict__ wsb, const float* __restrict__ bs,
                                          bf16_t* out, LAS unsigned char* lds, const int tid, const int bid) {
    constexpr int P = 272;
    const int wid = __builtin_amdgcn_readfirstlane(tid >> 6), lane = tid & 63, fr = lane & 15, fq = lane >> 4;
    LAS float* st = (LAS float*)lds; LAS unsigned char* vT = lds + 1024; LAS unsigned char* Wl = vT + 128 * P;
    f32x4 sv0, sv1; u32x4 gvw[4], wvb[4];
#define SGU_LOAD(u) do { const int _g = (u) & 7, _row0 = ((u) >> 8) * SEQ + (((u) >> 3) & 31) * 128; \
        const float* _sp = statsv + ((size_t)(_row0 + (tid >> 2)) * 16 + (tid & 3) * 4) * 2; sv0 = *(const f32x4*)_sp; sv1 = *(const f32x4*)(_sp + 4); \
        _Pragma("unroll") for (int i = 0; i < 4; ++i) gvw[i] = *(const u32x4*)(gv + (size_t)(_row0 + (tid & 127)) * GW + _g * 128 + ((tid >> 7) + 4 * i) * 8); \
        _Pragma("unroll") for (int i = 0; i < 4; ++i) wvb[i] = *(const u32x4*)(wsb + ((size_t)_g * 128 + (tid >> 4) + 32 * i) * 128 + (tid & 15) * 8); } while (0)
    if (bid < 1024) SGU_LOAD(bid);
    for (int u = bid; u < 1024; u += gridDim.x) {
        const int g = u & 7, chunk = (u >> 3) & 31, b = u >> 8, row0 = b * SEQ + chunk * 128;
        {
            const int r = tid >> 2, part = tid & 3;
            float s1 = (sv0[0] + sv0[2]) + (sv1[0] + sv1[2]), s2 = (sv0[1] + sv0[3]) + (sv1[1] + sv1[3]);
            s1 += shflx(s1, 1, lane); s1 += shflx(s1, 2, lane); s2 += shflx(s2, 1, lane); s2 += shflx(s2, 2, lane);
            const float mean = s1 * (1.f / GW), var = s2 * (1.f / GW) - mean * mean;
            if (part == 0) { st[2 * r] = mean; st[2 * r + 1] = __builtin_amdgcn_rsqf(var + LN_EPS); }
        }
        __syncthreads();
        {
            const int s = tid & 127; const float mean = st[2 * s], rstd = st[2 * s + 1];
#pragma unroll
            for (int i = 0; i < 4; ++i) {
                const int c8 = (tid >> 7) + 4 * i, col = g * 128 + c8 * 8;
                const u32x4 w = gvw[i];
                const f32x4 g0 = *(const f32x4*)(lng + col), g1 = *(const f32x4*)(lng + col + 4), b0 = *(const f32x4*)(lnb + col), b1 = *(const f32x4*)(lnb + col + 4);
                LAS bf16_t* vp = (LAS bf16_t*)(vT + (c8 * 8) * P) + s;
                vp[0 * (P / 2)] = f2bf((bf_lo(w.x) - mean) * rstd * g0[0] + b0[0]); vp[1 * (P / 2)] = f2bf((bf_hi(w.x) - mean) * rstd * g0[1] + b0[1]);
                vp[2 * (P / 2)] = f2bf((bf_lo(w.y) - mean) * rstd * g0[2] + b0[2]); vp[3 * (P / 2)] = f2bf((bf_hi(w.y) - mean) * rstd * g0[3] + b0[3]);
                vp[4 * (P / 2)] = f2bf((bf_lo(w.z) - mean) * rstd * g1[0] + b1[0]); vp[5 * (P / 2)] = f2bf((bf_hi(w.z) - mean) * rstd * g1[1] + b1[1]);
                vp[6 * (P / 2)] = f2bf((bf_lo(w.w) - mean) * rstd * g1[2] + b1[2]); vp[7 * (P / 2)] = f2bf((bf_hi(w.w) - mean) * rstd * g1[3] + b1[3]);
            }
#pragma unroll
            for (int i = 0; i < 4; ++i) {
                const int t = (tid >> 4) + 32 * i, s8 = (tid & 15) * 8;
                *(LAS u32x4*)(Wl + t * P + s8 * 2) = wvb[i];
            }
        }
        __syncthreads();
        if (u + (int)gridDim.x < 1024) SGU_LOAD(u + gridDim.x);
        {
            const int tf = wid, nks = (16 * tf + 15) / 32 + 1;
            const int t = 16 * tf + fr; const size_t ro = (size_t)(row0 + t) * GW + g * 128 + 4 * fq; const float bias = bs[g * 128 + t];
            u32x2 guw[8];
#pragma unroll
            for (int cf = 0; cf < 8; ++cf) guw[cf] = *(const u32x2*)(gu + ro + 16 * cf);
            f32x4 acc[8];
#pragma unroll
            for (int cf = 0; cf < 8; ++cf) acc[cf] = (f32x4){0.f, 0.f, 0.f, 0.f};
#pragma unroll
            for (int ks = 0; ks < 4; ++ks)
                if (ks < nks) {
                    const bf16x8 Bf = *(const LAS bf16x8*)(Wl + (16 * tf + fr) * P + (32 * ks + 8 * fq) * 2);
#pragma unroll
                    for (int cf = 0; cf < 8; ++cf) { const bf16x8 Af = *(const LAS bf16x8*)(vT + (16 * cf + fr) * P + (32 * ks + 8 * fq) * 2); acc[cf] = MFMA16(Af, Bf, acc[cf]); }
                }
#pragma unroll
            for (int cf = 0; cf < 8; ++cf) {
                const u32x2 gw = guw[cf];
                u32x2 o; o.x = cvt_pk_bf16(bf_lo(gw.x) * (acc[cf][0] + bias), bf_hi(gw.x) * (acc[cf][1] + bias)); o.y = cvt_pk_bf16(bf_lo(gw.y) * (acc[cf][2] + bias), bf_hi(gw.y) * (acc[cf][3] + bias));
                *(u32x2*)(out + ro + 16 * cf) = o;
            }
        }
    }
    __syncthreads();
#undef SGU_LOAD
}

__device__ __forceinline__ void swa_phase(const bf16_t* q, const bf16_t* kb, const bf16_t* vb, const float* __restrict__ sinks, bf16_t* out, LAS unsigned char* lds, const int tid, const int bid) {
    constexpr int KP = 144, VP = 528;
    const int wid = __builtin_amdgcn_readfirstlane(tid >> 6), lane = tid & 63, fr = lane & 15, fq = lane >> 4;
    LAS unsigned char* Kl = lds; LAS unsigned char* Vt = lds + 256 * KP;
    u32x4 kreg[4], vreg[4];
#define SWA_LOAD(u) do { const int _hkv = (u) & 3, _blk = ((u) >> 2) & 31, _rb = ((u) >> 7) * SEQ + _blk * 128; \
        _Pragma("unroll") for (int i = 0; i < 4; ++i) { const int key = (tid >> 3) + 64 * i; kreg[i] = (u32x4){0u, 0u, 0u, 0u}; \
            if (_blk > 0 || key >= 128) kreg[i] = *(const u32x4*)(kb + (size_t)(_rb - 128 + key) * KVW + _hkv * 64 + (tid & 7) * 8); } \
        _Pragma("unroll") for (int i = 0; i < 4; ++i) { const int key = lane + 64 * i; vreg[i] = (u32x4){0u, 0u, 0u, 0u}; \
            if (_blk > 0 || key >= 128) vreg[i] = *(const u32x4*)(vb + (size_t)(_rb - 128 + key) * KVW + _hkv * 64 + wid * 8); } } while (0)
    if (bid < 512) SWA_LOAD(bid);
    for (int u = bid; u < 512; u += gridDim.x) {
        const int hkv = u & 3, blk = (u >> 2) & 31, b = u >> 7, rowbase = b * SEQ + blk * 128;
#pragma unroll
        for (int i = 0; i < 4; ++i) {
            const int key = (tid >> 3) + 64 * i, d8 = (tid & 7) * 8;
            *(LAS u32x4*)(Kl + key * KP + d8 * 2) = kreg[i];
        }
#pragma unroll
        for (int i = 0; i < 4; ++i) {
            const int key = lane + 64 * i;
            const u32x4 w = vreg[i];
            LAS bf16_t* vp = (LAS bf16_t*)(Vt + (wid * 8) * VP) + key;
            vp[0 * (VP / 2)] = (bf16_t)(w.x & 0xffffu); vp[1 * (VP / 2)] = (bf16_t)(w.x >> 16); vp[2 * (VP / 2)] = (bf16_t)(w.y & 0xffffu); vp[3 * (VP / 2)] = (bf16_t)(w.y >> 16);
            vp[4 * (VP / 2)] = (bf16_t)(w.z & 0xffffu); vp[5 * (VP / 2)] = (bf16_t)(w.z >> 16); vp[6 * (VP / 2)] = (bf16_t)(w.w & 0xffffu); vp[7 * (VP / 2)] = (bf16_t)(w.w >> 16);
        }
        __syncthreads();
        if (u + (int)gridDim.x < 512) SWA_LOAD(u + gridDim.x);
        const int g = wid >> 1, half = wid & 1, h = hkv * 4 + g;
        const float sink = sinks[h];
        bf16x8 Qa[4], Qb[4];
#pragma unroll
        for (int mf = 0; mf < 4; ++mf) { const bf16_t* qp = q + (size_t)(rowbase + 64 * half + 16 * mf + fr) * AW + h * 64 + fq * 8; Qa[mf] = *(const bf16x8*)qp; Qb[mf] = *(const bf16x8*)(qp + 32); }
#pragma unroll
        for (int mf = 0; mf < 4; ++mf) {
            const int qb = 64 * half + 16 * mf, nb = qb >> 4, ql = qb + fr;
            const bf16x8 Q0 = Qa[mf], Q1 = Qb[mf];
            f32x4 s[9];
#pragma unroll
            for (int n = 0; n < 9; ++n) {
                const LAS unsigned char* kr = Kl + (16 * (nb + n) + fr) * KP + fq * 16;
                const bf16x8 K0 = *(const LAS bf16x8*)kr, K1 = *(const LAS bf16x8*)(kr + 64);
                s[n] = MFMA16(K0, Q0, ((f32x4){0.f, 0.f, 0.f, 0.f})); s[n] = MFMA16(K1, Q1, s[n]);
            }
            float mx = -INFINITY;
#pragma unroll
            for (int n = 0; n < 9; ++n)
#pragma unroll
                for (int j = 0; j < 4; ++j) {
                    const int kl = 16 * (nb + n) + 4 * fq + j;
                    const bool valid = (kl > ql) && (kl <= ql + 128) && (blk > 0 || kl >= 128);
                    s[n][j] = valid ? s[n][j] : -INFINITY; mx = fmaxf(mx, s[n][j]);
                }
            mx = fmaxf(mx, shflx(mx, 16, lane)); mx = fmaxf(mx, shflx(mx, 32, lane)); mx = fmaxf(mx, sink);
            float sum = 0.f;
#pragma unroll
            for (int n = 0; n < 9; ++n)
#pragma unroll
                for (int j = 0; j < 4; ++j) { const float pj = __expf(s[n][j] - mx); s[n][j] = pj; sum += pj; }
            sum += shflx(sum, 16, lane); sum += shflx(sum, 32, lane); sum += __expf(sink - mx);
            f32x4 o[4];
#pragma unroll
            for (int dn = 0; dn < 4; ++dn) o[dn] = (f32x4){0.f, 0.f, 0.f, 0.f};
#pragma unroll
            for (int pr = 0; pr < 5; ++pr) {
                const int n0 = 2 * pr;
                const bf16x8 Pf = as_bf16x8(pack8(s[n0], (n0 + 1 < 9) ? s[n0 + 1 < 9 ? n0 + 1 : 8] : ((f32x4){0.f, 0.f, 0.f, 0.f})));
                const int k0 = 16 * (nb + n0) + 4 * fq, k1 = (n0 + 1 < 9) ? k0 + 16 : k0;
#pragma unroll
                for (int dn = 0; dn < 4; ++dn) {
                    const LAS unsigned char* vr = Vt + (16 * dn + fr) * VP;
                    const u32x2 lo = *(const LAS u32x2*)(vr + k0 * 2), hi = *(const LAS u32x2*)(vr + k1 * 2);
                    o[dn] = MFMA16(as_bf16x8((u32x4){lo.x, lo.y, hi.x, hi.y}), Pf, o[dn]);
                }
            }
            const float inv = 1.f / sum;
            bf16_t* op = out + (size_t)(rowbase + ql) * AW + h * 64 + 4 * fq;
#pragma unroll
            for (int dn = 0; dn < 4; ++dn) { u32x2 w; w.x = cvt_pk_bf16(o[dn][0] * inv, o[dn][1] * inv); w.y = cvt_pk_bf16(o[dn][2] * inv, o[dn][3] * inv); *(u32x2*)(op + 16 * dn) = w; }
        }
        __syncthreads();
    }
}

__device__ __forceinline__ void xatt_phase(const bf16_t* xq, const bf16_t* xk, const bf16_t* xvt, bf16_t* xo, LAS unsigned char* lds, const int tid, const int bid) {
    constexpr int KP = 272, VP = 528;
    const int wid = __builtin_amdgcn_readfirstlane(tid >> 6), lane = tid & 63, fr = lane & 15, fq = lane >> 4;
    LAS unsigned char* Kl = lds; LAS unsigned char* Vt = lds + 256 * KP;
    for (int u = bid; u < 256; u += gridDim.x) {
        const int qt = u & 15, xh = (u >> 4) & 3, b = u >> 6;
        const bf16_t* kbase = xk + (size_t)(b * 256) * XW + xh * 128; const bf16_t* vtbase = xvt + (size_t)(xh * 128) * MROWS + b * 256;
#pragma unroll
        for (int i = 0; i < 8; ++i) {
            const int key = (tid >> 4) + 32 * i, d8 = (tid & 15) * 8;
            *(LAS u32x4*)(Kl + key * KP + d8 * 2) = *(const u32x4*)(kbase + (size_t)key * XW + d8);
        }
#pragma unroll
        for (int i = 0; i < 8; ++i) {
            const int d = tid >> 2, c = 4 * i + (tid & 3);
            *(LAS u32x4*)(Vt + d * VP + c * 16) = *(const u32x4*)(vtbase + (size_t)d * MROWS + c * 8);
        }
        __syncthreads();
        for (int mf = 0; mf < 2; ++mf) {
            const size_t qrow = (size_t)b * SEQ + qt * 256 + wid * 32 + mf * 16 + fr;
            const bf16_t* qp = xq + qrow * XW + xh * 128 + fq * 8;
            bf16x8 Q[4];
#pragma unroll
            for (int ks = 0; ks < 4; ++ks) Q[ks] = *(const bf16x8*)(qp + 32 * ks);
            f32x4 s[16];
#pragma unroll
            for (int n = 0; n < 16; ++n) {
                const LAS unsigned char* kr = Kl + (16 * n + fr) * KP + fq * 16;
                s[n] = (f32x4){0.f, 0.f, 0.f, 0.f};
#pragma unroll
                for (int ks = 0; ks < 4; ++ks) s[n] = MFMA16(*(const LAS bf16x8*)(kr + 64 * ks), Q[ks], s[n]);
            }
            float mx = -INFINITY;
#pragma unroll
            for (int n = 0; n < 16; ++n) mx = fmaxf(mx, fmaxf(fmaxf(s[n][0], s[n][1]), fmaxf(s[n][2], s[n][3])));
            mx = fmaxf(mx, shflx(mx, 16, lane)); mx = fmaxf(mx, shflx(mx, 32, lane));
            float sum = 0.f;
#pragma unroll
            for (int n = 0; n < 16; ++n)
#pragma unroll
                for (int j = 0; j < 4; ++j) { const float pj = __expf(s[n][j] - mx); s[n][j] = pj; sum += pj; }
            sum += shflx(sum, 16, lane); sum += shflx(sum, 32, lane);
            f32x4 o[8];
#pragma unroll
            for (int dn = 0; dn < 8; ++dn) o[dn] = (f32x4){0.f, 0.f, 0.f, 0.f};
#pragma unroll
            for (int pr = 0; pr < 8; ++pr) {
                const bf16x8 Pf = as_bf16x8(pack8(s[2 * pr], s[2 * pr + 1]));
                const int k0 = 32 * pr + 4 * fq;
#pragma unroll
                for (int dn = 0; dn < 8; ++dn) {
                    const LAS unsigned char* vr = Vt + (16 * dn + fr) * VP + k0 * 2;
                    const u32x2 lo = *(const LAS u32x2*)vr, hi = *(const LAS u32x2*)(vr + 32);
                    o[dn] = MFMA16(as_bf16x8((u32x4){lo.x, lo.y, hi.x, hi.y}), Pf, o[dn]);
                }
            }
            const float inv = 1.f / sum;
            bf16_t* op = xo + qrow * XW + xh * 128 + 4 * fq;
#pragma unroll
            for (int dn = 0; dn < 8; ++dn) { u32x2 w; w.x = cvt_pk_bf16(o[dn][0] * inv, o[dn][1] * inv); w.y = cvt_pk_bf16(o[dn][2] * inv, o[dn][3] * inv); *(u32x2*)(op + 16 * dn) = w; }
        }
        __syncthreads();
    }
}


#define XB_TMO      128
#define XB_XCNT(j)  (256  + 64 * (j))
#define XB_XSUB(j)  (1280 + 64 * (j))
#define XB_XGEN(j)  (2304 + 64 * (j))
#define XB_TOP      3328
#define XB_TOPGEN   3392
#define XCD_BAR_WORDS 3456
#define XB_SPIN_CAP (1u << 18)
__device__ __forceinline__ unsigned xb_ld(unsigned* p)              { return __hip_atomic_load(p, __ATOMIC_RELAXED, __HIP_MEMORY_SCOPE_AGENT); }
__device__ __forceinline__ unsigned xb_add(unsigned* p, unsigned v) { return __hip_atomic_fetch_add(p, v, __ATOMIC_RELAXED, __HIP_MEMORY_SCOPE_AGENT); }
__device__ __forceinline__ unsigned xb_xcc_id() { return (unsigned)__builtin_amdgcn_s_getreg((3 << 11) | 20) & 0xFu; }
#define XB_SPIN(cond, bar) do { unsigned _sp = 0; while (cond) { __builtin_amdgcn_s_sleep(1); \
    if ((++_sp & 255u) == 0u) { if (xb_ld(&(bar)[XB_TMO])) break; if (_sp > XB_SPIN_CAP) { atomicAdd(&(bar)[XB_TMO], 1u); break; } } } } while (0)
struct XcdBarrier { unsigned* bar; unsigned x; volatile LAS unsigned* st; };
__device__ __forceinline__ XcdBarrier xcd_barrier_post(unsigned* bar, volatile LAS unsigned* st) {
    XcdBarrier b; b.bar = bar; b.x = xb_xcc_id(); b.st = st;
    if (threadIdx.x == 0) (void)xb_add(&bar[XB_XCNT(b.x)], 1u);
    return b;
}
__device__ __forceinline__ void xcd_barrier_complete(unsigned* bar, unsigned x, unsigned& nloc, unsigned& nx) {
    const unsigned G = gridDim.x * gridDim.y * gridDim.z;
    unsigned sum, cnt, mine, sp = 0u;
    for (;;) {
        sum = 0u; cnt = 0u; mine = 0u;
#pragma unroll
        for (unsigned j = 0; j < 16; ++j) { const unsigned c = xb_ld(&bar[XB_XCNT(j)]); sum += c; cnt += (c > 0u) ? 1u : 0u; mine = (j == x) ? c : mine; }
        if (sum == G) break;
        __builtin_amdgcn_s_sleep(1);
        if ((++sp & 255u) == 0u) { if (xb_ld(&bar[XB_TMO])) break; if (sp > XB_SPIN_CAP) { atomicAdd(&bar[XB_TMO], 1u); break; } }
    }
    nloc = mine > 0u ? mine : 1u; nx = cnt > 0u ? cnt : 1u;
}
__device__ __forceinline__ void xcd_barrier(const XcdBarrier& b) {
    asm volatile("s_waitcnt vmcnt(0)" ::: "memory");
    __syncthreads();
    if (threadIdx.x == 0) {
        unsigned* bar = b.bar; asm volatile("" : "+s"(bar));
        __builtin_amdgcn_s_waitcnt(0);
        unsigned nloc = b.st[0], nx = b.st[1];
        if (nloc == 0u) { xcd_barrier_complete(bar, b.x, nloc, nx); b.st[0] = nloc; b.st[1] = nx; }
        const unsigned old = xb_add(&bar[XB_XSUB(b.x)], 1u);
        const unsigned gen = old / nloc;
        if (old + 1u == (gen + 1u) * nloc) {
            __builtin_amdgcn_fence(__ATOMIC_RELEASE, "agent");
            asm volatile("s_waitcnt vmcnt(0)" ::: "memory");
            const unsigned og = xb_add(&bar[XB_TOP], 1u);
            const unsigned tg = og / nx;
            if (og + 1u == (tg + 1u) * nx) xb_add(&bar[XB_TOPGEN], 1u);
            else XB_SPIN(xb_ld(&bar[XB_TOPGEN]) == tg, bar);
            __builtin_amdgcn_fence(__ATOMIC_ACQUIRE, "agent");
            xb_add(&bar[XB_XGEN(b.x)], 1u);
            asm volatile("s_waitcnt vmcnt(0)" ::: "memory");
        } else {
            XB_SPIN(xb_ld(&bar[XB_XGEN(b.x)]) == gen, bar);
            __builtin_amdgcn_fence(__ATOMIC_ACQUIRE, "agent");
            asm volatile("s_waitcnt vmcnt(0)" ::: "memory");
        }
    }
    __syncthreads();
}

__global__ void __launch_bounds__(512, 2) fwd_kernel(Params p) {
    extern __shared__ __attribute__((aligned(16))) unsigned char lds_raw[];
    LAS unsigned char* lds = (LAS unsigned char*)lds_raw;
    cg::grid_group grid = cg::this_grid();
    volatile LAS unsigned* xb_st = (volatile LAS unsigned*)(lds + LDS_BYTES - 16);
    if (threadIdx.x == 0) { xb_st[0] = 0u; xb_st[1] = 0u; }
    __syncthreads();
    const XcdBarrier xbar = xcd_barrier_post((unsigned*)(p.ws + WS_BAR), xb_st);
    if (p.ph_lo == 0) {
        unsigned char* ws = p.ws; asm volatile("" : "+s"(ws));
        int tid = threadIdx.x; asm volatile("" : "+v"(tid));
        int bid = blockIdx.x; asm volatile("" : "+s"(bid));
        cvt_bf16(p.in[0], (bf16_t*)(ws + WS_XB), (size_t)M * D, tid, bid); cvt_bf16(p.in[1], (bf16_t*)(ws + WS_MEMB), (size_t)MROWS * D, tid, bid); rope_table((float*)(ws + WS_ROPE), tid, bid);
    }
    for (int ph = p.ph_lo; ph < p.ph_hi; ++ph) {
        if (ph > p.ph_lo) { if (p.ph_hi < 0) grid.sync(); else xcd_barrier(xbar); }
        unsigned char* ws = p.ws; asm volatile("" : "+s"(ws));
        int tid = threadIdx.x; asm volatile("" : "+v"(tid));
        int bid = blockIdx.x; asm volatile("" : "+s"(bid));
        int z0 = 0; asm volatile("" : "+s"(z0));
        bf16_t* Wt_in = (bf16_t*)(ws + WS_WIN); bf16_t* Wt_bra = (bf16_t*)(ws + WS_WBRA); bf16_t* Wt_brb = (bf16_t*)(ws + WS_WBRB); bf16_t* Wt_o = (bf16_t*)(ws + WS_WO);
        bf16_t* Wt_xq = (bf16_t*)(ws + WS_WXQ); bf16_t* Wt_xkv = (bf16_t*)(ws + WS_WXKV); bf16_t* Wt_xo = (bf16_t*)(ws + WS_WXO); bf16_t* Wt_up = (bf16_t*)(ws + WS_WUP); bf16_t* Wt_dn = (bf16_t*)(ws + WS_WDN);
        bf16_t* TB = (bf16_t*)(ws + WS_XB);
        bf16_t* GU = (bf16_t*)(ws + WS_R1 + R1_GU); bf16_t* GV = (bf16_t*)(ws + WS_R1 + R1_GV); bf16_t* QB = (bf16_t*)(ws + WS_R1 + R1_Q); bf16_t* KB = (bf16_t*)(ws + WS_R1 + R1_K);
        bf16_t* VB = (bf16_t*)(ws + WS_R1 + R1_V); bf16_t* SA = (bf16_t*)(ws + WS_R1 + R1_SA); bf16_t* SB = (bf16_t*)(ws + WS_R1 + R1_SB); bf16_t* HB = (bf16_t*)(ws + WS_R1);
        bf16_t* MERGED = GU;
        bf16_t* SGUO = (bf16_t*)(ws + WS_R2); bf16_t* ATTO = (bf16_t*)(ws + WS_R2 + (size_t)M * GW * 2); bf16_t* XQ = SGUO; bf16_t* XO = ATTO;
        bf16_t* MEMB = (bf16_t*)(ws + WS_MEMB); bf16_t* XKV = (bf16_t*)(ws + WS_XKV); float* ROPE = (float*)(ws + WS_ROPE);
        float* STATSV = (float*)(ws + WS_STATSV); float* CSB = (float*)(ws + WS_CS);
        float* X = p.out;
        const int G = gridDim.x;
        if (ph == DEPTH * NPH) { ln_final(TB, X, p.in[z0 + 21] + (size_t)(DEPTH - 1) * D, p.in[z0 + 22] + (size_t)(DEPTH - 1) * D, tid, bid); break; }
        const int l = ph / NPH, k = ph % NPH;
        float* ST0 = (float*)(ws + WS_STATS) + (size_t)((3 * l + 0) & 1) * M * 64; float* ST1 = (float*)(ws + WS_STATS) + (size_t)((3 * l + 1) & 1) * M * 64;
        float* ST2 = (float*)(ws + WS_STATS) + (size_t)((3 * l + 2) & 1) * M * 64;
        const float* STP = ST1;
        switch (k) {
        case 0: {
#define VB(start, lo, n) ((bid >= (lo) && bid < (lo) + (n)) ? (bid - (lo) - (start) + 2 * (n)) % (n) : -1)
            conv_wt_fold(p.in[z0 + 14] + (size_t)l * D * XW, Wt_xq, XW, false, p.in[z0 + 12] + (size_t)l * D, p.in[z0 + 13] + (size_t)l * D, CSB + CS_XQ, (LAS float*)lds, tid, VB(0, G - 8, 8), 8);
            if (l == 0) {
                conv_wt(p.in[z0 + 2], Wt_in, D, NIN, true, (LAS float*)lds, tid, VB(0, 0, 248), 248);
                conv_wt(p.in[z0 + 9], Wt_bra, GW, D, false, (LAS float*)lds, tid, VB(216, 0, 248), 248);
                conv_wt(p.in[z0 + 10], Wt_brb, AW, D, false, (LAS float*)lds, tid, VB(96, 0, 248), 248);
                conv_wt(p.in[z0 + 11], Wt_o, D, D, false, (LAS float*)lds, tid, VB(224, 0, 248), 248);
                conv_wt(p.in[z0 + 15], Wt_xkv, D, 2 * XW, false, (LAS float*)lds, tid, VB(232, 0, 248), 248);
                conv_wt(p.in[z0 + 16], Wt_xo, XW, D, false, (LAS float*)lds, tid, VB(112, 0, 248), 248);
            } else {
                conv_wt_fold(p.in[z0 + 2] + (size_t)l * D * NIN, Wt_in, NIN, true, p.in[z0 + 21] + (size_t)(l - 1) * D, p.in[z0 + 22] + (size_t)(l - 1) * D, CSB + CS_IN, (LAS float*)lds, tid, VB(0, 0, 120), 120);
                conv_wt(p.in[z0 + 9] + (size_t)l * GW * D, Wt_bra, GW, D, false, (LAS float*)lds, tid, VB(0, 120, 128), 128);
                conv_wt(p.in[z0 + 10] + (size_t)l * AW * D, Wt_brb, AW, D, false, (LAS float*)lds, tid, VB(0, 120, 128), 128);
                conv_wt(p.in[z0 + 11] + (size_t)l * D * D, Wt_o, D, D, false, (LAS float*)lds, tid, VB(0, 120, 128), 128);
                conv_wt(p.in[z0 + 15] + (size_t)l * D * 2 * XW, Wt_xkv, D, 2 * XW, false, (LAS float*)lds, tid, VB(0, 120, 128), 128);
                conv_wt(p.in[z0 + 16] + (size_t)l * XW * D, Wt_xo, XW, D, false, (LAS float*)lds, tid, VB(64, 120, 128), 128);
            }
#undef VB
            {
                const float* wsf = p.in[z0 + 6] + (size_t)l * 8 * 128 * 128; bf16_t* wsbp = (bf16_t*)(ws + WS_WSB);
                for (int idx = bid * 512 + tid; idx < 8 * 128 * 128 / 4; idx += G * 512) {
                    const int e0 = idx * 4, t = (e0 >> 7) & 127, s4 = e0 & 127;
                    const f32x4 v = *(const f32x4*)(wsf + e0);
                    u32x2 pk; pk.x = cvt_pk_bf16(s4 + 0 <= t ? v[0] : 0.f, s4 + 1 <= t ? v[1] : 0.f); pk.y = cvt_pk_bf16(s4 + 2 <= t ? v[2] : 0.f, s4 + 3 <= t ? v[3] : 0.f);
                    *(u32x2*)(wsbp + e0) = pk;
                }
            }
        } break;
        case 1: {
            { pg8::Gemm g{TB, Wt_in, M, NIN, D, nullptr, nullptr}; pg8::StaticOrder S; S.init(M, NIN, G, bid);
              EpiIn E{GU, GV, QB, KB, VB, SA, SB, p.in[z0 + 3] + (size_t)l * 2 * D, ROPE, STATSV, Fold{l == 0 ? (const float*)nullptr : STP, CSB + CS_IN, NIN}};
              pg8::gemm_phase<EpiIn>(lds, g, S, E, tid); }
            asm volatile("" : "+v"(tid));
            { pg8::Gemm g{MEMB, Wt_xkv, MROWS, XW, D, nullptr, nullptr}; pg8::StaticOrder S; S.init(MROWS, XW, G, (bid + G / 2) % G);
              EpiB<0> E{XKV, XW, 1.0f, nullptr, Fold{nullptr, nullptr, 0}};
              pg8::gemm_phase<EpiB<0>>(lds, g, S, E, tid); }
            asm volatile("" : "+v"(tid));
            { pg8::Gemm g{Wt_xkv + (size_t)XW * D, MEMB, XW, MROWS, D, nullptr, nullptr}; pg8::StaticOrder S; S.init(XW, MROWS, G, (bid + G / 2 - 8) % G);
              EpiB<0> E{XKV + (size_t)MROWS * XW, MROWS, 1.0f, nullptr, Fold{nullptr, nullptr, 0}};
              pg8::gemm_phase<EpiB<0>>(lds, g, S, E, tid); }
            asm volatile("" : "+v"(tid));
            conv_wt(p.in[z0 + 20] + (size_t)l * FF * D, Wt_dn, FF, D, false, (LAS float*)lds, tid, bid >= 144 ? bid - 144 : -1, G - 144);
        } break;
        case 2: {
            sgu_phase(GU, GV, STATSV, p.in[z0 + 4] + (size_t)l * GW, p.in[z0 + 5] + (size_t)l * GW, (const bf16_t*)(ws + WS_WSB), p.in[z0 + 7] + (size_t)l * 8 * 128, SGUO, lds, tid, bid);
            asm volatile("" : "+v"(tid));
            swa_phase(QB, KB, VB, p.in[z0 + 8] + (size_t)l * 16, ATTO, lds, tid, bid);
        } break;
        case 3: {
            pg8::Gemm g{SGUO, Wt_bra, M, D, GW, ATTO, Wt_brb}; pg8::StaticOrder S; S.init(M, D, G, bid, 1); EpiBR E{MERGED, SA, SB}; pg8::gemm_phase<EpiBR>(lds, g, S, E, tid); } break;
        case 4: {
            pg8::Gemm g{MERGED, Wt_o, M, D, D, nullptr, nullptr}; pg8::StaticOrder S; S.init(M, D, G, bid, 1);
            EpiRes E{p.in[z0 + 0], nullptr, TB, p.in[z0 + 21] + (size_t)(l > 0 ? l - 1 : 0) * D, p.in[z0 + 22] + (size_t)(l > 0 ? l - 1 : 0) * D, ST0, Fold{l == 0 ? (const float*)nullptr : STP, nullptr, 0}};
            pg8::gemm_phase<EpiRes>(lds, g, S, E, tid); } break;
        case 5: { pg8::Gemm g{TB, Wt_xq, M, XW, D, nullptr, nullptr}; pg8::StaticOrder S; S.init(M, XW, G, bid); EpiB<0> E{XQ, XW, 0.08838834764831845f, nullptr, Fold{ST0, CSB + CS_XQ, XW}}; pg8::gemm_phase<EpiB<0>>(lds, g, S, E, tid);
            asm volatile("" : "+v"(tid));
            conv_wt_fold(p.in[z0 + 19] + (size_t)l * D * FF, Wt_up, FF, false, p.in[z0 + 17] + (size_t)l * D, p.in[z0 + 18] + (size_t)l * D, CSB + CS_UP, (LAS float*)lds, tid, bid >= 128 ? bid - 128 : -1, G - 128); } break;
        case 6: xatt_phase(XQ, XKV, XKV + (size_t)MROWS * XW, XO, lds, tid, bid); break;
        case 7: { pg8::Gemm g{XO, Wt_xo, M, D, XW, nullptr, nullptr}; pg8::StaticOrder S; S.init(M, D, G, bid);
            EpiRes E{nullptr, nullptr, TB, p.in[z0 + 12] + (size_t)l * D, p.in[z0 + 13] + (size_t)l * D, ST1, Fold{ST0, nullptr, 0}}; pg8::gemm_phase<EpiRes>(lds, g, S, E, tid); } break;
        case 8: { pg8::Gemm g{TB, Wt_up, M, FF, D, nullptr, nullptr}; pg8::StaticOrder S; S.init(M, FF, G, bid); EpiB<1> E{HB, FF, 1.f, nullptr, Fold{ST1, CSB + CS_UP, FF}}; pg8::gemm_phase<EpiB<1>>(lds, g, S, E, tid); } break;
        case 9: { pg8::Gemm g{HB, Wt_dn, M, D, FF, nullptr, nullptr}; pg8::StaticOrder S; S.init(M, D, G, bid, 1);
            EpiRes E{nullptr, nullptr, TB, p.in[z0 + 17] + (size_t)l * D, p.in[z0 + 18] + (size_t)l * D, ST2, Fold{ST1, nullptr, 0}}; pg8::gemm_phase<EpiRes>(lds, g, S, E, tid); } break;
        }
    }
}

extern "C" void kernel_launch(void* const* d_in, const int* in_sizes, int n_in, void* d_out, int out_size, void* d_ws, size_t ws_size, hipStream_t stream) {
    static int grid = 0;
    if (grid == 0) {
        if (n_in != 23 || out_size != M * D || ws_size < WS_END) { fprintf(stderr, "kernel_launch: unexpected shapes (n_in %d out %d ws %zu need %zu)\n", n_in, out_size, ws_size, (size_t)WS_END); grid = -1; return; }
        int dev = 0, cus = 0, per_cu = 0;
        hipGetDevice(&dev);
        hipDeviceGetAttribute(&cus, hipDeviceAttributeMultiprocessorCount, dev);
        if (hipFuncSetAttribute((const void*)fwd_kernel, hipFuncAttributeMaxDynamicSharedMemorySize, LDS_BYTES) != hipSuccess) { fprintf(stderr, "kernel_launch: hipFuncSetAttribute failed\n"); grid = -1; return; }
        if (hipOccupancyMaxActiveBlocksPerMultiprocessor(&per_cu, (const void*)fwd_kernel, 512, LDS_BYTES) != hipSuccess || per_cu < 1) { fprintf(stderr, "kernel_launch: occupancy query gave %d\n", per_cu); per_cu = 1; }
        (void)hipGetLastError();
        grid = cus;
    }
    if (grid < 0) return;
    Params p{};
    for (int i = 0; i < 23; ++i) p.in[i] = (const float*)d_in[i];
    p.out = (float*)d_out; p.ws = (unsigned char*)d_ws;
#if LAUNCH_PER_PHASE
    for (int ph = 0; ph < DEPTH * NPH + 1; ++ph) {
        p.ph_lo = ph; p.ph_hi = ph + 1;
        hipLaunchKernelGGL(fwd_kernel, dim3(grid), dim3(512), LDS_BYTES, stream, p);
    }
#else
    p.ph_lo = 0; p.ph_hi = DEPTH * NPH + 1;
    (void)hipMemsetAsync((unsigned char*)d_ws + WS_BAR, 0, (size_t)XCD_BAR_WORDS_C * 4, stream);
    void* args[] = {&p};
    hipError_t e = hipLaunchCooperativeKernel((const void*)fwd_kernel, dim3(grid), dim3(512), args, LDS_BYTES, stream);
    if (e != hipSuccess) fprintf(stderr, "cooperative launch failed: %s (grid %d)\n", hipGetErrorString(e), grid);
#endif
}
```
